# Optimizing an MI355X kernel written in HIP

```python
import jax, jax.numpy as jnp
from jax import lax
import numpy as np

D_MODEL = 1024
BATCH = 1
SEQ = 16384
DEPTH = 1

GRID_W = 64
CTX_LEN = 256
D_MIX = D_MODEL
D_CONV = D_MIX // 2
D_SSM = D_MIX - D_CONV
SSM_GROUP = 16
N_GROUPS = D_SSM // SSM_GROUP
STATE = 64
CONV_WIDTH = 31
D_FF = ((8 * D_MODEL + 3 * 256 - 1) // (3 * 256)) * 256
D_IN = 2 * D_CONV + D_SSM
N_MOD = 6
EPS = 1e-6

kernel_name = "hybrid_conformer_conv_s5_prefix_dit_block"


def rms_norm(x, g):
    xf = x.astype(jnp.float32)
    y = xf * lax.rsqrt(jnp.mean(xf * xf, axis=-1, keepdims=True) + EPS)
    return (y * g.astype(jnp.float32)).astype(x.dtype)


def layer_norm(x, g, b):
    xf = x.astype(jnp.float32)
    mu = jnp.mean(xf, axis=-1, keepdims=True)
    var = jnp.mean(jnp.square(xf - mu), axis=-1, keepdims=True)
    y = (xf - mu) * lax.rsqrt(var + EPS) * g.astype(jnp.float32) + b.astype(jnp.float32)
    return y.astype(x.dtype)


def modulate(h, shift, scale):
    return h * (1.0 + scale) + shift


def conv_module(a, w, b, ln_g, ln_b):
    pad = CONV_WIDTH // 2
    y = lax.conv_general_dilated(
        a, w[:, None, :].astype(a.dtype), window_strides=(1,), padding=((pad, pad),),
        dimension_numbers=("NWC", "WIO", "NWC"), feature_group_count=a.shape[-1])
    y = y + b
    return jax.nn.silu(layer_norm(y, ln_g, ln_b))


def glu(z):
    v, g = jnp.split(z, 2, axis=-1)
    return v * jax.nn.sigmoid(g)


def s5_discretize(a_re, a_im, log_dt, b_re, b_im):
    A = lax.complex(a_re.astype(jnp.float32), a_im.astype(jnp.float32))
    dt = jnp.exp(log_dt.astype(jnp.float32))[:, None]
    a_bar = jnp.exp(A * dt)
    Bm = lax.complex(b_re.astype(jnp.float32), b_im.astype(jnp.float32))
    b_bar = ((a_bar - 1.0) / A)[:, :, None] * Bm
    return a_bar, b_bar


def linear_scan(a_bar, bu, s0, reverse):
    if s0 is not None:
        first = -1 if reverse else 0
        bu = bu.at[:, first].add(a_bar * s0)
    a = jnp.broadcast_to(a_bar, bu.shape)

    def combine(e1, e2):
        a1, b1 = e1
        a2, b2 = e2
        return a1 * a2, a2 * b1 + b2

    _, states = lax.associative_scan(combine, (a, bu), reverse=reverse, axis=1)
    return states


def s5_block(u_ctx, u_lat, a_re, a_im, log_dt, b_re, b_im, c_re, c_im, d_skip, w_glu, b_glu,
             need_ctx_out):
    B_, L, _ = u_lat.shape
    uc = u_ctx.astype(jnp.float32)
    ul = u_lat.astype(jnp.float32)
    ucg = uc.reshape(B_, uc.shape[1], N_GROUPS, SSM_GROUP)
    ulg = ul.reshape(B_, L, N_GROUPS, SSM_GROUP)
    d = d_skip.astype(jnp.float32).reshape(N_GROUPS, SSM_GROUP)
    y_lat = ulg * d
    y_ctx = ucg * d
    for direction, reverse in ((0, False), (1, True)):
        a_bar, b_bar = s5_discretize(a_re[direction], a_im[direction], log_dt[direction],
                                     b_re[direction], b_im[direction])
        c_mat = lax.complex(c_re[direction].astype(jnp.float32),
                            c_im[direction].astype(jnp.float32))
        s_ctx = linear_scan(a_bar, jnp.einsum('gpc,blgc->blgp', b_bar, ucg), None, reverse)
        s_final = s_ctx[:, 0] if reverse else s_ctx[:, -1]
        s_lat = linear_scan(a_bar, jnp.einsum('gpc,blgc->blgp', b_bar, ulg), s_final, reverse)
        y_lat = y_lat + jnp.einsum('blgp,gcp->blgc', s_lat, c_mat).real
        if need_ctx_out:
            y_ctx = y_ctx + jnp.einsum('blgp,gcp->blgc', s_ctx, c_mat).real

    def out_glu(y):
        g = jax.nn.gelu(y.reshape(y.shape[0], y.shape[1], D_SSM))
        return g * jax.nn.sigmoid(g @ w_glu.astype(jnp.float32) + b_glu.astype(jnp.float32))

    out_lat = out_glu(y_lat).astype(u_lat.dtype)
    out_ctx = out_glu(y_ctx).astype(u_ctx.dtype) if need_ctx_out else None
    return out_lat, out_ctx


def swiglu(h, w_gate_up, w_down):
    g, u = jnp.split(h @ w_gate_up, 2, axis=-1)
    return (jax.nn.silu(g) * u) @ w_down


def setup_inputs(seed: int = 0) -> dict:
    key = jax.random.key(seed)
    ks = jax.random.split(key, 32)
    f32 = jnp.float32
    nrm = lambda k, shape, s: jax.random.normal(k, shape, f32) * s
    n_idx = jnp.arange(STATE, dtype=f32)
    return {
        "x": nrm(ks[0], (BATCH, SEQ, D_MODEL), 1.0),
        "c": nrm(ks[1], (BATCH, D_MODEL), 1.0),
        "ctx": nrm(ks[2], (BATCH, CTX_LEN, D_MODEL), 1.0),
        "c_ctx": nrm(ks[3], (D_MODEL,), 1.0),
        "w_mod": nrm(ks[4], (DEPTH, D_MODEL, N_MOD * D_MODEL), 0.5 * D_MODEL ** -0.5),
        "b_mod": nrm(ks[5], (DEPTH, N_MOD * D_MODEL), 0.01),
        "norm1_g": 1.0 + nrm(ks[6], (DEPTH, D_MODEL), 0.01),
        "w_in": nrm(ks[7], (DEPTH, D_MODEL, D_IN), D_MODEL ** -0.5),
        "conv_w": nrm(ks[8], (DEPTH, CONV_WIDTH, D_CONV), CONV_WIDTH ** -0.5),
        "conv_b": nrm(ks[9], (DEPTH, D_CONV), 0.01),
        "conv_ln_g": 1.0 + nrm(ks[10], (DEPTH, D_CONV), 0.01),
        "conv_ln_b": nrm(ks[11], (DEPTH, D_CONV), 0.01),
        "ssm_a_re": -0.5 * jnp.exp(nrm(ks[12], (DEPTH, 2, N_GROUPS, STATE), 0.01)),
        "ssm_a_im": np.pi * n_idx + nrm(ks[13], (DEPTH, 2, N_GROUPS, STATE), 0.01),
        "ssm_log_dt": jax.random.uniform(ks[14], (DEPTH, 2, N_GROUPS), f32,
                                         np.log(0.001), np.log(0.1)),
        "ssm_b_re": nrm(ks[15], (DEPTH, 2, N_GROUPS, STATE, SSM_GROUP), (2 * SSM_GROUP) ** -0.5),
        "ssm_b_im": nrm(ks[16], (DEPTH, 2, N_GROUPS, STATE, SSM_GROUP), (2 * SSM_GROUP) ** -0.5),
        "ssm_c_re": nrm(ks[17], (DEPTH, 2, N_GROUPS, SSM_GROUP, STATE), STATE ** -0.5),
        "ssm_c_im": nrm(ks[18], (DEPTH, 2, N_GROUPS, SSM_GROUP, STATE), STATE ** -0.5),
        "ssm_d": nrm(ks[19], (DEPTH, D_SSM), 1.0),
        "ssm_w_glu": nrm(ks[20], (DEPTH, D_SSM, D_SSM), D_SSM ** -0.5),
        "ssm_b_glu": nrm(ks[21], (DEPTH, D_SSM), 0.01),
        "w_out": nrm(ks[22], (DEPTH, D_MIX, D_MODEL), D_MIX ** -0.5),
        "norm2_g": 1.0 + nrm(ks[23], (DEPTH, D_MODEL), 0.01),
        "w_gate_up": nrm(ks[24], (DEPTH, D_MODEL, 2 * D_FF), D_MODEL ** -0.5),
        "w_down": nrm(ks[25], (DEPTH, D_FF, D_MODEL), D_FF ** -0.5),
        "final_norm_g": 1.0 + nrm(ks[26], (D_MODEL,), 0.01),
    }


def reference(x, c, ctx, c_ctx, w_mod, b_mod, norm1_g, w_in, conv_w, conv_b, conv_ln_g,
              conv_ln_b, ssm_a_re, ssm_a_im, ssm_log_dt, ssm_b_re, ssm_b_im, ssm_c_re,
              ssm_c_im, ssm_d, ssm_w_glu, ssm_b_glu, w_out, norm2_g, w_gate_up, w_down,
              final_norm_g):
    B_, L, _ = x.shape
    rows = L // GRID_W
    silu_c = jax.nn.silu(c)
    silu_cc = jax.nn.silu(c_ctx)
    for i in range(DEPTH):
        need_ctx = i < DEPTH - 1
        sh1, sc1, g1, sh2, sc2, g2 = jnp.split(silu_c @ w_mod[i] + b_mod[i], N_MOD, axis=-1)
        sh1, sc1, g1, sh2, sc2, g2 = (t[:, None, :] for t in (sh1, sc1, g1, sh2, sc2, g2))
        csh1, csc1, cg1, csh2, csc2, cg2 = jnp.split(silu_cc @ w_mod[i] + b_mod[i], N_MOD, axis=-1)

        h = modulate(rms_norm(x, norm1_g[i]), sh1, sc1)
        hc = modulate(rms_norm(ctx, norm1_g[i]), csh1, csc1)
        z = h @ w_in[i]
        a = glu(z[..., :2 * D_CONV])
        a_cols = a.reshape(B_, rows, GRID_W, D_CONV).transpose(0, 2, 1, 3)
        a_cols = a_cols.reshape(B_ * GRID_W, rows, D_CONV)
        y_conv = conv_module(a_cols, conv_w[i], conv_b[i], conv_ln_g[i], conv_ln_b[i])
        y_conv = y_conv.reshape(B_, GRID_W, rows, D_CONV).transpose(0, 2, 1, 3)
        y_conv = y_conv.reshape(B_, L, D_CONV)
        u_ctx = hc @ w_in[i][:, 2 * D_CONV:]
        y_ssm, y_ssm_ctx = s5_block(u_ctx, z[..., 2 * D_CONV:], ssm_a_re[i], ssm_a_im[i],
                                    ssm_log_dt[i], ssm_b_re[i], ssm_b_im[i], ssm_c_re[i],
                                    ssm_c_im[i], ssm_d[i], ssm_w_glu[i], ssm_b_glu[i], need_ctx)
        mix = jnp.concatenate([y_conv, y_ssm], axis=-1) @ w_out[i]
        x = x + g1 * mix

        h2 = modulate(rms_norm(x, norm2_g[i]), sh2, sc2)
        x = x + g2 * swiglu(h2, w_gate_up[i], w_down[i])

        if need_ctx:
            ac = glu(hc @ w_in[i][:, :2 * D_CONV])
            y_conv_c = conv_module(ac, conv_w[i], conv_b[i], conv_ln_g[i], conv_ln_b[i])
            ctx = ctx + cg1 * (jnp.concatenate([y_conv_c, y_ssm_ctx], axis=-1) @ w_out[i])
            hc2 = modulate(rms_norm(ctx, norm2_g[i]), csh2, csc2)
            ctx = ctx + cg2 * swiglu(hc2, w_gate_up[i], w_down[i])
    return rms_norm(x, final_norm_g)
```

```cpp
#include <hip/hip_runtime.h>
#include <stdint.h>
#include <cstdio>

typedef unsigned short h16;

namespace cfg {
constexpr int L = 16384, D = 1024, CTX = 256, MR = L + CTX;
constexpr int DC = 512, DS = 512, NG = 32, SG = 16, NP = 64, CW = 31, DFF = 2816, DIN = 1536;
constexpr int GW = 64, ROWS = 256;
constexpr int T = 32, NC = L / T, KY = SG * T + 256;
constexpr float EPS = 1e-6f;
constexpr size_t MiB = 1u << 20;
constexpr size_t WS_CTL = 0, WS_MOD = 1 * MiB, WS_S0 = 1 * MiB + 64 * 1024, WS_SSQ = 1 * MiB + 128 * 1024;
constexpr size_t WS_WIN = 2 * MiB, WS_WGLU = 5 * MiB, WS_WOUT = 6 * MiB, WS_WGU = 8 * MiB, WS_WDN = 19 * MiB;
constexpr size_t WS_WY = 25 * MiB, WS_PT = 49 * MiB, WS_UCTX = 57 * MiB, WS_KTAB = 58 * MiB;
constexpr size_t WS_H = 60 * MiB, WS_ACONV = 93 * MiB, WS_UEXT = 109 * MiB, WS_E = 133 * MiB, WS_ACT = 60 * MiB;
constexpr size_t WS_GACT = 149 * MiB, WS_MIX = 165 * MiB, WS_H2 = 197 * MiB;
constexpr size_t WS_ZTMP = 149 * MiB;
constexpr size_t WS_YDIR = 165 * MiB;
}
using namespace cfg;

__device__ __forceinline__ unsigned f2bf(float f) { unsigned u = __float_as_uint(f); return (u + 0x7fffu + ((u >> 16) & 1u)) >> 16; }
__device__ __forceinline__ float bf2f(h16 v) { return __uint_as_float(((unsigned)v) << 16); }
__device__ __forceinline__ float sigmoidf_(float x) { return 1.f / (1.f + __expf(-x)); }
__device__ __forceinline__ float siluf_(float x) { return x / (1.f + __expf(-x)); }
__device__ __forceinline__ float gelu_tanh(float x) { const float u = 0.7978845608028654f * (x + 0.044715f * x * x * x); return 0.5f * x * (1.f + tanhf(u)); }

__global__ void k_mod(const float* c, const float* cc, const float* w_mod, const float* b_mod, float* MOD) {
    const int n = blockIdx.x * blockDim.x + threadIdx.x; if (n >= 6 * D) return;
    float a0 = 0.f, a1 = 0.f;
    for (int k = 0; k < D; ++k) { const float w = w_mod[(size_t)k * (6 * D) + n]; a0 += siluf_(c[k]) * w; a1 += siluf_(cc[k]) * w; }
    MOD[n] = a0 + b_mod[n]; MOD[6 * D + n] = a1 + b_mod[n];
}

__device__ __forceinline__ float block_sum(float v, float* red) {
    for (int o = 32; o > 0; o >>= 1) v += __shfl_xor(v, o);
    __syncthreads();
    if ((threadIdx.x & 63) == 0) red[threadIdx.x >> 6] = v;
    __syncthreads();
    float s = 0.f; for (int i = 0; i < (int)(blockDim.x >> 6); ++i) s += red[i];
    return s;
}
__global__ void __launch_bounds__(256) k_norm_mod(const float* xa, const float* xb, int nlat, const float* gain, const float* MOD, int ish, int isc, h16* out) {
    __shared__ float red[8];
    const int m = blockIdx.x; const bool lat = m < nlat;
    const float* xr = lat ? xa + (size_t)m * D : xb + (size_t)(m - nlat) * D;
    const float* md = MOD + (lat ? 0 : 6 * D);
    float v[4]; float ss = 0.f;
    for (int i = 0; i < 4; ++i) { v[i] = xr[threadIdx.x + 256 * i]; ss += v[i] * v[i]; }
    const float tot = block_sum(ss, red);
    const float rstd = rsqrtf(tot * (1.f / D) + EPS);
    for (int i = 0; i < 4; ++i) { const int k = threadIdx.x + 256 * i;
        const float y = v[i] * rstd * gain[k]; out[(size_t)m * D + k] = (h16)f2bf(y * (1.f + md[isc * D + k]) + md[ish * D + k]); }
}

struct MapId { static __device__ int map(int n) { return n; } };
struct MapIn { static __device__ int map(int n) { if (n >= 1024) return n; const int pn = n >> 8, lc = n & 255; return lc < 128 ? 128 * pn + lc : 512 + 128 * pn + (lc - 128); } };
struct MapGu { static __device__ int map(int n) { const int q = n >> 8, lc = n & 255; return lc < 128 ? 128 * q + lc : DFF + 128 * q + (lc - 128); } };
template <class Map>
__global__ void __launch_bounds__(256) k_transpose(const float* W, int K, int N, h16* WT) {
    __shared__ float tile[32][33];
    const int n0 = blockIdx.x * 32, k0 = blockIdx.y * 32, tx = threadIdx.x & 31, ty = threadIdx.x >> 5;
    for (int i = ty; i < 32; i += 8) tile[i][tx] = W[(size_t)(k0 + i) * N + Map::map(n0 + tx)];
    __syncthreads();
    for (int i = ty; i < 32; i += 8) WT[(size_t)(n0 + i) * K + k0 + tx] = (h16)f2bf(tile[tx][i]);
}

struct ADesc { const h16* p; long sM; long sKB; long kb; long sBatch; };
template <class Epi>
__global__ void __launch_bounds__(256) k_gemm_simple(ADesc A, const h16* Bt, int ldb, long sBb, int M, int N, int K, Epi epi) {
    __shared__ float As[8][128], Bs[8][128];
    const int z = blockIdx.z, m0 = blockIdx.y * 128, n0 = blockIdx.x * 128, tid = threadIdx.x, tx = tid & 15, ty = tid >> 4;
    const h16* Ap = A.p + (size_t)z * A.sBatch; const h16* Bp = Bt + (size_t)z * sBb;
    float acc[8][8];
#pragma unroll
    for (int i = 0; i < 8; ++i)
#pragma unroll
        for (int j = 0; j < 8; ++j) acc[i][j] = 0.f;
    const int lr = tid >> 1, lk = (tid & 1) * 4;
    for (int k0 = 0; k0 < K; k0 += 8) {
        const int k = k0 + lk; const int kbw = (int)A.kb;
        const uint2 av = *(const uint2*)(Ap + (size_t)(k / kbw) * A.sKB + (size_t)(m0 + lr) * A.sM + (k % kbw));
        const uint2 bv = *(const uint2*)(Bp + (size_t)(n0 + lr) * ldb + k);
        __syncthreads();
        As[lk + 0][lr] = __uint_as_float(av.x << 16); As[lk + 1][lr] = __uint_as_float(av.x & 0xffff0000u);
        As[lk + 2][lr] = __uint_as_float(av.y << 16); As[lk + 3][lr] = __uint_as_float(av.y & 0xffff0000u);
        Bs[lk + 0][lr] = __uint_as_float(bv.x << 16); Bs[lk + 1][lr] = __uint_as_float(bv.x & 0xffff0000u);
        Bs[lk + 2][lr] = __uint_as_float(bv.y << 16); Bs[lk + 3][lr] = __uint_as_float(bv.y & 0xffff0000u);
        __syncthreads();
#pragma unroll
        for (int kk = 0; kk < 8; ++kk) {
            float a[8], b[8];
#pragma unroll
            for (int i = 0; i < 8; ++i) { a[i] = As[kk][ty * 8 + i]; b[i] = Bs[kk][tx * 8 + i]; }
#pragma unroll
            for (int i = 0; i < 8; ++i)
#pragma unroll
                for (int j = 0; j < 8; ++j) acc[i][j] += a[i] * b[j];
        }
    }
#pragma unroll
    for (int i = 0; i < 8; ++i)
#pragma unroll
        for (int j = 0; j < 8; ++j) epi(z, m0 + ty * 8 + i, n0 + tx * 8 + j, acc[i][j]);
}
struct EpiStoreF32 { float* C; long ldc; long sBatch; long mlim; __device__ void operator()(int z, int m, int n, float v) const { C[(size_t)z * sBatch + (size_t)m * ldc + n] = v; } };
struct EpiGlu { const h16* Gact; const float* b_glu; h16* MIX; __device__ void operator()(int, int m, int n, float v) const {
    const float g = bf2f(Gact[(size_t)(n >> 4) * (L * 16) + (size_t)m * 16 + (n & 15)]); MIX[(size_t)m * 1024 + 512 + n] = (h16)f2bf(g * sigmoidf_(v + b_glu[n])); } };
struct EpiOut { const float* x; const float* g1; float* X1; __device__ void operator()(int, int m, int n, float v) const { X1[(size_t)m * D + n] = x[(size_t)m * D + n] + g1[n] * v; } };
struct EpiDown { const float* g2; float* X; __device__ void operator()(int, int m, int n, float v) const { X[(size_t)m * D + n] += g2[n] * v; } };

__global__ void __launch_bounds__(256) k_epi1(const float* Z, h16* Aconv, h16* Uext, float* Uctx) {
    const int m = blockIdx.x;
    const float* z = Z + (size_t)m * DIN;
    if (m < L) {
        for (int ch = threadIdx.x; ch < DC; ch += 256) { const int pn = ch >> 7, lc = ch & 127; const float v = z[256 * pn + lc], g = z[256 * pn + 128 + lc];
            Aconv[(size_t)m * DC + ch] = (h16)f2bf(v * sigmoidf_(g)); }
        for (int ch = threadIdx.x; ch < DS; ch += 256) { const int g = ch >> 4, c = ch & 15;
            Uext[((size_t)g * NC + (m / T)) * KY + (m % T) * SG + c] = (h16)f2bf(z[1024 + ch]); }
    } else {
        for (int ch = threadIdx.x; ch < DS; ch += 256) Uctx[(size_t)(m - L) * DS + ch] = z[1024 + ch];
    }
}

__global__ void __launch_bounds__(512) k_conv(const h16* Aconv, const float* cw, const float* cb, const float* lg, const float* lb, h16* MIX) {
    __shared__ float red[8];
    const int t = blockIdx.x, r = t / GW, c = t % GW, ch = threadIdx.x;
    float y = cb[ch];
    for (int k = 0; k < CW; ++k) { const int rr = r + k - CW / 2; if (rr >= 0 && rr < ROWS) y += cw[k * DC + ch] * bf2f(Aconv[(size_t)(rr * GW + c) * DC + ch]); }
    const float mu = block_sum(y, red) * (1.f / DC);
    const float d = y - mu;
    const float var = block_sum(d * d, red) * (1.f / DC);
    const float o = d * rsqrtf(var + EPS) * lg[ch] + lb[ch];
    MIX[(size_t)t * 1024 + ch] = (h16)f2bf(siluf_(o));
}

__global__ void __launch_bounds__(64) k_ssm_naive(const float* a_re, const float* a_im, const float* log_dt, const float* b_re, const float* b_im,
                                                   const float* c_re, const float* c_im, const h16* Uext, const float* Uctx, float* Ydir) {
    __shared__ float2 Cs[16][64];
    __shared__ float2 Ss[4][64];
    const int dir = blockIdx.x / NG, g = blockIdx.x % NG, p = threadIdx.x, dg = dir * NG + g;
    const float are = a_re[dg * NP + p], aim = a_im[dg * NP + p], dt = expf(log_dt[dg]);
    const float xr = are * dt, yi = aim * dt;
    float sn, cs; sincosf(yi, &sn, &cs);
    const float em1 = expm1f(xr), shalf = sinf(0.5f * yi);
    const float abr = (em1 + 1.f) * cs, abi = (em1 + 1.f) * sn;
    const float nr = em1 * cs - 2.f * shalf * shalf, ni = abi;
    const float den = are * are + aim * aim;
    const float cr = (nr * are + ni * aim) / den, ci = (ni * are - nr * aim) / den;
    float bbr[16], bbi[16];
#pragma unroll
    for (int c = 0; c < 16; ++c) { const float br = b_re[((size_t)dg * NP + p) * SG + c], bi = b_im[((size_t)dg * NP + p) * SG + c]; bbr[c] = cr * br - ci * bi; bbi[c] = cr * bi + ci * br; }
#pragma unroll
    for (int c = 0; c < 16; ++c) Cs[c][p] = make_float2(c_re[((size_t)dg * SG + c) * NP + p], c_im[((size_t)dg * SG + c) * NP + p]);
    float sr = 0.f, si = 0.f;
    for (int jj = 0; jj < CTX; ++jj) {
        const int j = dir ? CTX - 1 - jj : jj;
        float bur = 0.f, bui = 0.f;
#pragma unroll
        for (int c = 0; c < 16; ++c) { const float u = Uctx[(size_t)j * DS + g * SG + c]; bur += bbr[c] * u; bui += bbi[c] * u; }
        const float nsr = abr * sr - abi * si + bur, nsi = abr * si + abi * sr + bui; sr = nsr; si = nsi;
    }
    __syncthreads();
    for (int t4 = 0; t4 < L / 4; ++t4) {
#pragma unroll
        for (int q = 0; q < 4; ++q) {
            const int tt = t4 * 4 + q, t = dir ? L - 1 - tt : tt;
            const h16* up = Uext + ((size_t)g * NC + (t / T)) * KY + (t % T) * SG;
            float bur = 0.f, bui = 0.f;
#pragma unroll
            for (int c = 0; c < 16; ++c) { const float u = bf2f(up[c]); bur += bbr[c] * u; bui += bbi[c] * u; }
            const float nsr = abr * sr - abi * si + bur, nsi = abr * si + abi * sr + bui; sr = nsr; si = nsi;
            Ss[q][p] = make_float2(sr, si);
        }
        __syncthreads();
        {
            const int q = p >> 4, c = p & 15; float acc = 0.f;
            for (int pp = 0; pp < NP; ++pp) { const float2 cc = Cs[c][pp], s = Ss[q][pp]; acc += cc.x * s.x - cc.y * s.y; }
            const int tt = t4 * 4 + q, t = dir ? L - 1 - tt : tt;
            Ydir[((size_t)dir * L + t) * DS + g * SG + c] = acc;
        }
        __syncthreads();
    }
}
__global__ void __launch_bounds__(256) k_ssm_fin(const h16* Uext, const float* Ydir, const float* dskip, h16* Gact) {
    const int t = blockIdx.x;
    for (int ch = threadIdx.x; ch < DS; ch += 256) { const int g = ch >> 4, c = ch & 15;
        const float u = bf2f(Uext[((size_t)g * NC + (t / T)) * KY + (t % T) * SG + c]);
        const float y = u * dskip[ch] + Ydir[(size_t)t * DS + ch] + Ydir[((size_t)L + t) * DS + ch];
        Gact[(size_t)g * (L * 16) + (size_t)t * 16 + c] = (h16)f2bf(gelu_tanh(y)); }
}

__global__ void __launch_bounds__(256) k_epi_ffn(const float* Z, int row0, h16* ACT) {
    const int m = blockIdx.x; const float* z = Z + (size_t)m * (2 * DFF);
    for (int j = threadIdx.x; j < DFF; j += 256) { const int q = j >> 7, lc = j & 127; const float gt = z[256 * q + lc], up = z[256 * q + 128 + lc];
        ACT[(size_t)(row0 + m) * DFF + j] = (h16)f2bf(siluf_(gt) * up); }
}
__global__ void __launch_bounds__(256) k_final(float* X, const float* fg) {
    __shared__ float red[8];
    const int m = blockIdx.x; float* xr = X + (size_t)m * D;
    float v[4]; float ss = 0.f;
    for (int i = 0; i < 4; ++i) { v[i] = xr[threadIdx.x + 256 * i]; ss += v[i] * v[i]; }
    const float rstd = rsqrtf(block_sum(ss, red) * (1.f / D) + EPS);
    for (int i = 0; i < 4; ++i) { const int k = threadIdx.x + 256 * i; xr[k] = v[i] * rstd * fg[k]; }
}

extern "C" void kernel_launch(void* const* d_in, const int* in_sizes, int n_in, void* d_out, int out_size, void* d_ws, size_t ws_size, hipStream_t stream) {
    const float* x = (const float*)d_in[0]; const float* c = (const float*)d_in[1]; const float* ctx = (const float*)d_in[2]; const float* c_ctx = (const float*)d_in[3];
    const float* w_mod = (const float*)d_in[4]; const float* b_mod = (const float*)d_in[5]; const float* norm1_g = (const float*)d_in[6]; const float* w_in = (const float*)d_in[7];
    const float* conv_w = (const float*)d_in[8]; const float* conv_b = (const float*)d_in[9]; const float* conv_ln_g = (const float*)d_in[10]; const float* conv_ln_b = (const float*)d_in[11];
    const float* a_re = (const float*)d_in[12]; const float* a_im = (const float*)d_in[13]; const float* log_dt = (const float*)d_in[14];
    const float* b_re = (const float*)d_in[15]; const float* b_im = (const float*)d_in[16]; const float* c_re = (const float*)d_in[17]; const float* c_im = (const float*)d_in[18];
    const float* ssm_d = (const float*)d_in[19]; const float* w_glu = (const float*)d_in[20]; const float* b_glu = (const float*)d_in[21]; const float* w_out = (const float*)d_in[22];
    const float* norm2_g = (const float*)d_in[23]; const float* w_gu = (const float*)d_in[24]; const float* w_dn = (const float*)d_in[25]; const float* fin_g = (const float*)d_in[26];
    unsigned char* ws = (unsigned char*)d_ws; float* out = (float*)d_out;
    if (n_in != 27 || ws_size < 256 * MiB) { fprintf(stderr, "kernel_launch: unexpected n_in %d / ws %zu\n", n_in, ws_size); return; }
    float* MOD = (float*)(ws + WS_MOD);
    h16* WinT = (h16*)(ws + WS_WIN); h16* WgluT = (h16*)(ws + WS_WGLU); h16* WoutT = (h16*)(ws + WS_WOUT); h16* WguT = (h16*)(ws + WS_WGU); h16* WdnT = (h16*)(ws + WS_WDN);
    h16* H = (h16*)(ws + WS_H); h16* Aconv = (h16*)(ws + WS_ACONV); h16* Uext = (h16*)(ws + WS_UEXT); float* Uctx = (float*)(ws + WS_UCTX);
    h16* ACT = (h16*)(ws + WS_ACT); h16* Gact = (h16*)(ws + WS_GACT); h16* MIX = (h16*)(ws + WS_MIX); h16* H2 = (h16*)(ws + WS_H2);
    float* ZTMP = (float*)(ws + WS_ZTMP); float* YDIR = (float*)(ws + WS_YDIR);

    k_mod<<<6 * D / 256, 256, 0, stream>>>(c, c_ctx, w_mod, b_mod, MOD);
    k_transpose<MapIn><<<dim3(DIN / 32, D / 32), 256, 0, stream>>>(w_in, D, DIN, WinT);
    k_transpose<MapId><<<dim3(DS / 32, DS / 32), 256, 0, stream>>>(w_glu, DS, DS, WgluT);
    k_transpose<MapId><<<dim3(D / 32, D / 32), 256, 0, stream>>>(w_out, D, D, WoutT);
    k_transpose<MapGu><<<dim3(2 * DFF / 32, D / 32), 256, 0, stream>>>(w_gu, D, 2 * DFF, WguT);
    k_transpose<MapId><<<dim3(D / 32, DFF / 32), 256, 0, stream>>>(w_dn, DFF, D, WdnT);
    k_norm_mod<<<MR, 256, 0, stream>>>(x, ctx, L, norm1_g, MOD, 0, 1, H);
    { ADesc A{H, D, 0, 1 << 30, 0}; EpiStoreF32 E{ZTMP, DIN, 0, 0};
      k_gemm_simple<EpiStoreF32><<<dim3(DIN / 128, MR / 128, 1), 256, 0, stream>>>(A, WinT, D, 0, MR, DIN, D, E); }
    k_epi1<<<MR, 256, 0, stream>>>(ZTMP, Aconv, Uext, Uctx);
    k_ssm_naive<<<2 * NG, 64, 0, stream>>>(a_re, a_im, log_dt, b_re, b_im, c_re, c_im, Uext, Uctx, YDIR);
    k_ssm_fin<<<L, 256, 0, stream>>>(Uext, YDIR, ssm_d, Gact);
    k_conv<<<L, 512, 0, stream>>>(Aconv, conv_w, conv_b, conv_ln_g, conv_ln_b, MIX);
    { ADesc A{Gact, 16, (long)L * 16, 16, 0}; EpiGlu E{Gact, b_glu, MIX};
      k_gemm_simple<EpiGlu><<<dim3(DS / 128, L / 128, 1), 256, 0, stream>>>(A, WgluT, DS, 0, L, DS, DS, E); }
    { ADesc A{MIX, D, 0, 1 << 30, 0}; EpiOut E{x, MOD + 2 * D, out};
      k_gemm_simple<EpiOut><<<dim3(D / 128, L / 128, 1), 256, 0, stream>>>(A, WoutT, D, 0, L, D, D, E); }
    k_norm_mod<<<L, 256, 0, stream>>>(out, out, L, norm2_g, MOD, 3, 4, H2);
    constexpr int RCH = 2048;
    for (int r0 = 0; r0 < L; r0 += RCH) {
        ADesc A{H2 + (size_t)r0 * D, D, 0, 1 << 30, 0}; EpiStoreF32 E{ZTMP, 2 * DFF, 0, 0};
        k_gemm_simple<EpiStoreF32><<<dim3(2 * DFF / 128, RCH / 128, 1), 256, 0, stream>>>(A, WguT, D, 0, RCH, 2 * DFF, D, E);
        k_epi_ffn<<<RCH, 256, 0, stream>>>(ZTMP, r0, ACT);
    }
    { ADesc A{ACT, DFF, 0, 1 << 30, 0}; EpiDown E{MOD + 5 * D, out};
      k_gemm_simple<EpiDown><<<dim3(D / 128, L / 128, 1), 256, 0, stream>>>(A, WdnT, DFF, 0, L, D, DFF, E); }
    k_final<<<L, 256, 0, stream>>>(out, fin_g);
}
```

```cpp
#include <hip/hip_runtime.h>
#include <stdint.h>
#include <cstdio>

typedef unsigned short h16;
typedef unsigned u32x4g __attribute__((ext_vector_type(4)));
#ifndef FAST_SSM
#define FAST_SSM 1
#endif
#ifndef FAST_G1
#define FAST_G1 1
#endif
#ifndef FAST_GLU
#define FAST_GLU 1
#endif
#ifndef FAST_OUT
#define FAST_OUT 1
#endif
#ifndef FAST_FFN
#define FAST_FFN 1
#endif

namespace cfg {
constexpr int L = 16384, D = 1024, CTX = 256, MR = L + CTX;
constexpr int DC = 512, DS = 512, NG = 32, SG = 16, NP = 64, CW = 31, DFF = 2816, DIN = 1536;
constexpr int GW = 64, ROWS = 256;
constexpr int T = 32, NC = L / T, KY = SG * T + 256;
constexpr float EPS = 1e-6f;
constexpr size_t MiB = 1u << 20;
constexpr size_t WS_CTL = 0, WS_MOD = 1 * MiB, WS_S0 = 1 * MiB + 64 * 1024, WS_SSQ = 1 * MiB + 128 * 1024;
constexpr size_t WS_WIN = 2 * MiB, WS_WGLU = 5 * MiB, WS_WOUT = 6 * MiB, WS_WGU = 8 * MiB, WS_WDN = 19 * MiB;
constexpr size_t WS_WY = 25 * MiB, WS_PT = 49 * MiB, WS_UCTX = 57 * MiB, WS_ECTX = 57 * MiB + 512 * 1024, WS_KTAB = 58 * MiB;
constexpr size_t WS_H = 60 * MiB, WS_ACONV = 93 * MiB, WS_UEXT = 109 * MiB, WS_E = 133 * MiB, WS_ACT = 60 * MiB;
constexpr size_t WS_GACT = 149 * MiB, WS_MIX = 165 * MiB, WS_H2 = 197 * MiB;
constexpr size_t WS_ZTMP = 149 * MiB;
constexpr size_t WS_YDIR = 165 * MiB;
}
using namespace cfg;

__device__ __forceinline__ unsigned f2bf(float f) { unsigned u = __float_as_uint(f); return (u + 0x7fffu + ((u >> 16) & 1u)) >> 16; }
__device__ __forceinline__ float bf2f(h16 v) { return __uint_as_float(((unsigned)v) << 16); }
__device__ __forceinline__ float sigmoidf_(float x) { return 1.f / (1.f + __expf(-x)); }
__device__ __forceinline__ float siluf_(float x) { return x / (1.f + __expf(-x)); }
__device__ __forceinline__ float gelu_tanh(float x) { const float u = 0.7978845608028654f * (x + 0.044715f * x * x * x); return 0.5f * x * (1.f + tanhf(u)); }

__global__ void k_mod(const float* c, const float* cc, const float* w_mod, const float* b_mod, float* MOD) {
    const int n = blockIdx.x * blockDim.x + threadIdx.x; if (n >= 6 * D) return;
    float a0 = 0.f, a1 = 0.f;
    for (int k = 0; k < D; ++k) { const float w = w_mod[(size_t)k * (6 * D) + n]; a0 += siluf_(c[k]) * w; a1 += siluf_(cc[k]) * w; }
    MOD[n] = a0 + b_mod[n]; MOD[6 * D + n] = a1 + b_mod[n];
}

__device__ __forceinline__ float block_sum(float v, float* red) {
    for (int o = 32; o > 0; o >>= 1) v += __shfl_xor(v, o);
    __syncthreads();
    if ((threadIdx.x & 63) == 0) red[threadIdx.x >> 6] = v;
    __syncthreads();
    float s = 0.f; for (int i = 0; i < (int)(blockDim.x >> 6); ++i) s += red[i];
    return s;
}
__global__ void __launch_bounds__(256) k_norm_mod(const float* xa, const float* xb, int nlat, const float* gain, const float* MOD, int ish, int isc, h16* out) {
    __shared__ float red[8];
    const int m = blockIdx.x; const bool lat = m < nlat;
    const float* xr = lat ? xa + (size_t)m * D : xb + (size_t)(m - nlat) * D;
    const float* md = MOD + (lat ? 0 : 6 * D);
    float v[4]; float ss = 0.f;
    for (int i = 0; i < 4; ++i) { v[i] = xr[threadIdx.x + 256 * i]; ss += v[i] * v[i]; }
    const float tot = block_sum(ss, red);
    const float rstd = rsqrtf(tot * (1.f / D) + EPS);
    for (int i = 0; i < 4; ++i) { const int k = threadIdx.x + 256 * i;
        const float y = v[i] * rstd * gain[k]; out[(size_t)m * D + k] = (h16)f2bf(y * (1.f + md[isc * D + k]) + md[ish * D + k]); }
}

struct MapId { static __device__ int map(int n) { return n; } };
struct MapIn { static __device__ int map(int n) { if (n >= 1024) return n; const int pn = n >> 8, lc = n & 255; return lc < 128 ? 128 * pn + lc : 512 + 128 * pn + (lc - 128); } };
struct MapGu { static __device__ int map(int n) { const int q = n >> 8, lc = n & 255; return lc < 128 ? 128 * q + lc : DFF + 128 * q + (lc - 128); } };
template <class Map>
__global__ void __launch_bounds__(256) k_transpose(const float* W, int K, int N, h16* WT) {
    __shared__ float tile[32][33];
    const int n0 = blockIdx.x * 32, k0 = blockIdx.y * 32, tx = threadIdx.x & 31, ty = threadIdx.x >> 5;
    for (int i = ty; i < 32; i += 8) tile[i][tx] = W[(size_t)(k0 + i) * N + Map::map(n0 + tx)];
    __syncthreads();
    for (int i = ty; i < 32; i += 8) WT[(size_t)(n0 + i) * K + k0 + tx] = (h16)f2bf(tile[tx][i]);
}

struct ADesc { const h16* p; long sM; long sKB; long kb; long sBatch; };
template <class Epi>
__global__ void __launch_bounds__(256) k_gemm_simple(ADesc A, const h16* Bt, int ldb, long sBb, int M, int N, int K, Epi epi) {
    __shared__ float As[8][128], Bs[8][128];
    const int z = blockIdx.z, m0 = blockIdx.y * 128, n0 = blockIdx.x * 128, tid = threadIdx.x, tx = tid & 15, ty = tid >> 4;
    const h16* Ap = A.p + (size_t)z * A.sBatch; const h16* Bp = Bt + (size_t)z * sBb;
    float acc[8][8];
#pragma unroll
    for (int i = 0; i < 8; ++i)
#pragma unroll
        for (int j = 0; j < 8; ++j) acc[i][j] = 0.f;
    const int lr = tid >> 1, lk = (tid & 1) * 4;
    for (int k0 = 0; k0 < K; k0 += 8) {
        const int k = k0 + lk; const int kbw = (int)A.kb;
        const uint2 av = *(const uint2*)(Ap + (size_t)(k / kbw) * A.sKB + (size_t)(m0 + lr) * A.sM + (k % kbw));
        const uint2 bv = *(const uint2*)(Bp + (size_t)(n0 + lr) * ldb + k);
        __syncthreads();
        As[lk + 0][lr] = __uint_as_float(av.x << 16); As[lk + 1][lr] = __uint_as_float(av.x & 0xffff0000u);
        As[lk + 2][lr] = __uint_as_float(av.y << 16); As[lk + 3][lr] = __uint_as_float(av.y & 0xffff0000u);
        Bs[lk + 0][lr] = __uint_as_float(bv.x << 16); Bs[lk + 1][lr] = __uint_as_float(bv.x & 0xffff0000u);
        Bs[lk + 2][lr] = __uint_as_float(bv.y << 16); Bs[lk + 3][lr] = __uint_as_float(bv.y & 0xffff0000u);
        __syncthreads();
#pragma unroll
        for (int kk = 0; kk < 8; ++kk) {
            float a[8], b[8];
#pragma unroll
            for (int i = 0; i < 8; ++i) { a[i] = As[kk][ty * 8 + i]; b[i] = Bs[kk][tx * 8 + i]; }
#pragma unroll
            for (int i = 0; i < 8; ++i)
#pragma unroll
                for (int j = 0; j < 8; ++j) acc[i][j] += a[i] * b[j];
        }
    }
#pragma unroll
    for (int i = 0; i < 8; ++i)
#pragma unroll
        for (int j = 0; j < 8; ++j) epi(z, m0 + ty * 8 + i, n0 + tx * 8 + j, acc[i][j]);
}
struct EpiStoreF32 { float* C; long ldc; long sBatch; long mlim; __device__ void operator()(int z, int m, int n, float v) const { C[(size_t)z * sBatch + (size_t)m * ldc + n] = v; } };
struct EpiGlu { const h16* Gact; const float* b_glu; h16* MIX; __device__ void operator()(int, int m, int n, float v) const {
    const float g = bf2f(Gact[(size_t)(n >> 4) * (L * 16) + (size_t)m * 16 + (n & 15)]); MIX[(size_t)m * 1024 + 512 + n] = (h16)f2bf(g * sigmoidf_(v + b_glu[n])); } };
struct EpiOut { const float* x; const float* g1; float* X1; __device__ void operator()(int, int m, int n, float v) const { X1[(size_t)m * D + n] = x[(size_t)m * D + n] + g1[n] * v; } };
struct EpiDown { const float* g2; float* X; __device__ void operator()(int, int m, int n, float v) const { X[(size_t)m * D + n] += g2[n] * v; } };

__global__ void __launch_bounds__(256) k_epi1(const float* Z, h16* Aconv, h16* Uext, float* Uctx) {
    const int m = blockIdx.x;
    const float* z = Z + (size_t)m * DIN;
    if (m < L) {
        for (int ch = threadIdx.x; ch < DC; ch += 256) { const int pn = ch >> 7, lc = ch & 127; const float v = z[256 * pn + lc], g = z[256 * pn + 128 + lc];
            Aconv[(size_t)m * DC + ch] = (h16)f2bf(v * sigmoidf_(g)); }
        for (int ch = threadIdx.x; ch < DS; ch += 256) { const int g = ch >> 4, c = ch & 15;
            Uext[((size_t)g * NC + (m / T)) * KY + (m % T) * SG + c] = (h16)f2bf(z[1024 + ch]); }
    } else {
        for (int ch = threadIdx.x; ch < DS; ch += 256) Uctx[(size_t)(m - L) * DS + ch] = z[1024 + ch];
    }
}

__global__ void __launch_bounds__(512) k_conv(const h16* Aconv, const float* cw, const float* cb, const float* lg, const float* lb, h16* MIX) {
    __shared__ float red[8];
    const int t = blockIdx.x, r = t / GW, c = t % GW, ch = threadIdx.x;
    float y = cb[ch];
    for (int k = 0; k < CW; ++k) { const int rr = r + k - CW / 2; if (rr >= 0 && rr < ROWS) y += cw[k * DC + ch] * bf2f(Aconv[(size_t)(rr * GW + c) * DC + ch]); }
    const float mu = block_sum(y, red) * (1.f / DC);
    const float d = y - mu;
    const float var = block_sum(d * d, red) * (1.f / DC);
    const float o = d * rsqrtf(var + EPS) * lg[ch] + lb[ch];
    MIX[(size_t)t * 1024 + ch] = (h16)f2bf(siluf_(o));
}

__global__ void __launch_bounds__(64) k_ssm_naive(const float* a_re, const float* a_im, const float* log_dt, const float* b_re, const float* b_im,
                                                   const float* c_re, const float* c_im, const h16* Uext, const float* Uctx, float* Ydir) {
    __shared__ float2 Cs[16][64];
    __shared__ float2 Ss[4][64];
    const int dir = blockIdx.x / NG, g = blockIdx.x % NG, p = threadIdx.x, dg = dir * NG + g;
    const float are = a_re[dg * NP + p], aim = a_im[dg * NP + p], dt = expf(log_dt[dg]);
    const float xr = are * dt, yi = aim * dt;
    float sn, cs; sincosf(yi, &sn, &cs);
    const float em1 = expm1f(xr), shalf = sinf(0.5f * yi);
    const float abr = (em1 + 1.f) * cs, abi = (em1 + 1.f) * sn;
    const float nr = em1 * cs - 2.f * shalf * shalf, ni = abi;
    const float den = are * are + aim * aim;
    const float cr = (nr * are + ni * aim) / den, ci = (ni * are - nr * aim) / den;
    float bbr[16], bbi[16];
#pragma unroll
    for (int c = 0; c < 16; ++c) { const float br = b_re[((size_t)dg * NP + p) * SG + c], bi = b_im[((size_t)dg * NP + p) * SG + c]; bbr[c] = cr * br - ci * bi; bbi[c] = cr * bi + ci * br; }
#pragma unroll
    for (int c = 0; c < 16; ++c) Cs[c][p] = make_float2(c_re[((size_t)dg * SG + c) * NP + p], c_im[((size_t)dg * SG + c) * NP + p]);
    float sr = 0.f, si = 0.f;
    for (int jj = 0; jj < CTX; ++jj) {
        const int j = dir ? CTX - 1 - jj : jj;
        float bur = 0.f, bui = 0.f;
#pragma unroll
        for (int c = 0; c < 16; ++c) { const float u = Uctx[(size_t)j * DS + g * SG + c]; bur += bbr[c] * u; bui += bbi[c] * u; }
        const float nsr = abr * sr - abi * si + bur, nsi = abr * si + abi * sr + bui; sr = nsr; si = nsi;
    }
    __syncthreads();
    for (int t4 = 0; t4 < L / 4; ++t4) {
#pragma unroll
        for (int q = 0; q < 4; ++q) {
            const int tt = t4 * 4 + q, t = dir ? L - 1 - tt : tt;
            const h16* up = Uext + ((size_t)g * NC + (t / T)) * KY + (t % T) * SG;
            float bur = 0.f, bui = 0.f;
#pragma unroll
            for (int c = 0; c < 16; ++c) { const float u = bf2f(up[c]); bur += bbr[c] * u; bui += bbi[c] * u; }
            const float nsr = abr * sr - abi * si + bur, nsi = abr * si + abi * sr + bui; sr = nsr; si = nsi;
            Ss[q][p] = make_float2(sr, si);
        }
        __syncthreads();
        {
            const int q = p >> 4, c = p & 15; float acc = 0.f;
            for (int pp = 0; pp < NP; ++pp) { const float2 cc = Cs[c][pp], s = Ss[q][pp]; acc += cc.x * s.x - cc.y * s.y; }
            const int tt = t4 * 4 + q, t = dir ? L - 1 - tt : tt;
            Ydir[((size_t)dir * L + t) * DS + g * SG + c] = acc;
        }
        __syncthreads();
    }
}
__global__ void __launch_bounds__(256) k_ssm_fin(const h16* Uext, const float* Ydir, const float* dskip, h16* Gact) {
    const int t = blockIdx.x;
    for (int ch = threadIdx.x; ch < DS; ch += 256) { const int g = ch >> 4, c = ch & 15;
        const float u = bf2f(Uext[((size_t)g * NC + (t / T)) * KY + (t % T) * SG + c]);
        const float y = u * dskip[ch] + Ydir[(size_t)t * DS + ch] + Ydir[((size_t)L + t) * DS + ch];
        Gact[(size_t)g * (L * 16) + (size_t)t * 16 + c] = (h16)f2bf(gelu_tanh(y)); }
}

struct SsmPar { float x, y, abr, abi, cr, ci; };
__device__ __forceinline__ SsmPar ssm_par(const float* a_re, const float* a_im, const float* log_dt, int dg, int p) {
    SsmPar r; const float are = a_re[dg * NP + p], aim = a_im[dg * NP + p], dt = expf(log_dt[dg]);
    r.x = are * dt; r.y = aim * dt;
    float sn, cs; sincosf(r.y, &sn, &cs);
    const float em1 = expm1f(r.x), shalf = sinf(0.5f * r.y);
    r.abr = (em1 + 1.f) * cs; r.abi = (em1 + 1.f) * sn;
    const float nr = em1 * cs - 2.f * shalf * shalf, ni = r.abi, den = are * are + aim * aim;
    r.cr = (nr * are + ni * aim) / den; r.ci = (ni * are - nr * aim) / den;
    return r;
}
__device__ __forceinline__ float2 cpow_n(const SsmPar& r, int n) { float sn, cs; sincosf((float)n * r.y, &sn, &cs); const float e = expf((float)n * r.x); return make_float2(e * cs, e * sn); }
__device__ __forceinline__ float2 cmul(float2 a, float2 b) { return make_float2(a.x * b.x - a.y * b.y, a.x * b.y + a.y * b.x); }

__device__ __forceinline__ void ktab_item(int item, int tid, float2* Cs  , float2* Bs  , float2* Ap  ,
                                          const float* a_re, const float* a_im, const float* log_dt, const float* b_re, const float* b_im, const float* c_re, const float* c_im, float* KT) {
    const int dq = item & 3, dg2 = item >> 2, g = dg2 >> 1, dir = dg2 & 1, dg = dir * NG + g;
    __syncthreads();
    if (tid < 64) { const int p = tid; const SsmPar r = ssm_par(a_re, a_im, log_dt, dg, p);
#pragma unroll
        for (int c = 0; c < 16; ++c) { const float br = b_re[((size_t)dg * NP + p) * SG + c], bi = b_im[((size_t)dg * NP + p) * SG + c]; Bs[p * 16 + c] = make_float2(r.cr * br - r.ci * bi, r.cr * bi + r.ci * br); }
#pragma unroll
        for (int dd = 0; dd < 8; ++dd) Ap[dd * 64 + p] = cpow_n(r, 8 * dq + dd); }
    for (int e = tid; e < 1024; e += 256) { const int c = e >> 6, p = e & 63; Cs[c * 64 + p] = make_float2(c_re[((size_t)dg * SG + c) * NP + p], c_im[((size_t)dg * SG + c) * NP + p]); }
    __syncthreads();
    const int c = tid >> 4, cp = tid & 15;
    float acc[8];
#pragma unroll
    for (int dd = 0; dd < 8; ++dd) acc[dd] = 0.f;
    for (int p = 0; p < NP; ++p) { const float2 m = cmul(Cs[c * 64 + p], Bs[p * 16 + cp]);
#pragma unroll
        for (int dd = 0; dd < 8; ++dd) { const float2 a = Ap[dd * 64 + p]; acc[dd] += m.x * a.x - m.y * a.y; } }
#pragma unroll
    for (int dd = 0; dd < 8; ++dd) KT[(((size_t)g * 2 + dir) * T + 8 * dq + dd) * 256 + tid] = acc[dd];
}
__global__ void __launch_bounds__(256) k_ktab(const float* a_re, const float* a_im, const float* log_dt, const float* b_re, const float* b_im, const float* c_re, const float* c_im, float* KT) {
    __shared__ float2 Cs[1024], Bs[1024], Ap[512];
    for (int item = blockIdx.x; item < NG * 2 * 4; item += gridDim.x) ktab_item(item, threadIdx.x, Cs, Bs, Ap, a_re, a_im, log_dt, b_re, b_im, c_re, c_im, KT);
}
__device__ __forceinline__ void wy_toep(size_t idx, const float* KT, const float* dskip, h16* WyT) {
    const int j = idx & 31, c = (idx >> 5) & 15, i = (idx >> 9) & 31, g = (int)(idx >> 14);
    const int d = i - j, ad = d < 0 ? -d : d;
    const float* kf = KT + (((size_t)g * 2 + 0) * T + ad) * 256 + c * 16; const float* kr = KT + (((size_t)g * 2 + 1) * T + ad) * 256 + c * 16;
    float v[16];
#pragma unroll
    for (int q = 0; q < 16; ++q) { const float f = kf[q], r = kr[q]; v[q] = d > 0 ? f : (d < 0 ? r : f + r + (q == c ? dskip[g * SG + c] : 0.f)); }
    u32x4g w0, w1;
    w0.x = f2bf(v[0]) | (f2bf(v[1]) << 16); w0.y = f2bf(v[2]) | (f2bf(v[3]) << 16); w0.z = f2bf(v[4]) | (f2bf(v[5]) << 16); w0.w = f2bf(v[6]) | (f2bf(v[7]) << 16);
    w1.x = f2bf(v[8]) | (f2bf(v[9]) << 16); w1.y = f2bf(v[10]) | (f2bf(v[11]) << 16); w1.z = f2bf(v[12]) | (f2bf(v[13]) << 16); w1.w = f2bf(v[14]) | (f2bf(v[15]) << 16);
    u32x4g* o = (u32x4g*)(WyT + ((size_t)g * 512 + i * 16 + c) * KY + j * 16); o[0] = w0; o[1] = w1;
}
__device__ __forceinline__ void wy_q(size_t idx, const float* a_re, const float* a_im, const float* log_dt, const float* c_re, const float* c_im, h16* WyT) {
    const int p = idx & 63, dir = (idx >> 6) & 1, i = (idx >> 7) & 31, g = (int)(idx >> 12), dg = dir * NG + g;
    const SsmPar r = ssm_par(a_re, a_im, log_dt, dg, p);
    const float2 ap = cpow_n(r, dir == 0 ? i + 1 : T - i);
#pragma unroll
    for (int c = 0; c < 16; ++c) { const float2 cc = make_float2(c_re[((size_t)dg * SG + c) * NP + p], c_im[((size_t)dg * SG + c) * NP + p]); const float2 q = cmul(cc, ap);
        *(unsigned*)(WyT + ((size_t)g * 512 + i * 16 + c) * KY + 512 + dir * 128 + 2 * p) = f2bf(q.x) | (f2bf(-q.y) << 16); }
}
__device__ __forceinline__ void pt_fill(size_t idx, const float* a_re, const float* a_im, const float* log_dt, const float* b_re, const float* b_im, h16* PT) {
    const int j = idx & 31, p = (idx >> 5) & 63, dir = (idx >> 11) & 1, g = (int)(idx >> 12), dg = dir * NG + g;
    const SsmPar r = ssm_par(a_re, a_im, log_dt, dg, p);
    const float2 ap = cpow_n(r, dir == 0 ? T - 1 - j : j); const float2 co = cmul(ap, make_float2(r.cr, r.ci));
    float vr[16], vi[16];
#pragma unroll
    for (int c = 0; c < 16; ++c) { const float2 v = cmul(co, make_float2(b_re[((size_t)dg * NP + p) * SG + c], b_im[((size_t)dg * NP + p) * SG + c])); vr[c] = v.x; vi[c] = v.y; }
    u32x4g w;
    u32x4g* o = (u32x4g*)(PT + ((size_t)g * 256 + dir * 128 + 2 * p) * 512 + j * 16);
    w.x = f2bf(vr[0]) | (f2bf(vr[1]) << 16); w.y = f2bf(vr[2]) | (f2bf(vr[3]) << 16); w.z = f2bf(vr[4]) | (f2bf(vr[5]) << 16); w.w = f2bf(vr[6]) | (f2bf(vr[7]) << 16); o[0] = w;
    w.x = f2bf(vr[8]) | (f2bf(vr[9]) << 16); w.y = f2bf(vr[10]) | (f2bf(vr[11]) << 16); w.z = f2bf(vr[12]) | (f2bf(vr[13]) << 16); w.w = f2bf(vr[14]) | (f2bf(vr[15]) << 16); o[1] = w;
    o += 512 * 2 / 16;
    w.x = f2bf(vi[0]) | (f2bf(vi[1]) << 16); w.y = f2bf(vi[2]) | (f2bf(vi[3]) << 16); w.z = f2bf(vi[4]) | (f2bf(vi[5]) << 16); w.w = f2bf(vi[6]) | (f2bf(vi[7]) << 16); o[0] = w;
    w.x = f2bf(vi[8]) | (f2bf(vi[9]) << 16); w.y = f2bf(vi[10]) | (f2bf(vi[11]) << 16); w.z = f2bf(vi[12]) | (f2bf(vi[13]) << 16); w.w = f2bf(vi[14]) | (f2bf(vi[15]) << 16); o[1] = w;
}
__global__ void __launch_bounds__(256) k_ssm_mats(const float* a_re, const float* a_im, const float* log_dt, const float* b_re, const float* b_im, const float* c_re, const float* c_im,
                                                  const float* dskip, const float* KT, h16* WyT, h16* PT) {
    const size_t tid = (size_t)blockIdx.x * 256 + threadIdx.x, nth = (size_t)gridDim.x * 256;
    for (size_t i = tid; i < (size_t)NG * 32 * 16 * 32; i += nth) wy_toep(i, KT, dskip, WyT);
    for (size_t i = tid; i < (size_t)NG * 32 * 2 * 64; i += nth) wy_q(i, a_re, a_im, log_dt, c_re, c_im, WyT);
    for (size_t i = tid; i < (size_t)NG * 2 * 64 * 32; i += nth) pt_fill(i, a_re, a_im, log_dt, b_re, b_im, PT);
}
__device__ __forceinline__ void ctx_chunk_state(int item, int p, const float* a_re, const float* a_im, const float* log_dt, const float* b_re, const float* b_im, const float* Uctx, float2* Ectx) {
    const int ck = item & 7, g = (item >> 3) & 31, dir = item >> 8, dg = dir * NG + g;
    const SsmPar r = ssm_par(a_re, a_im, log_dt, dg, p);
    float bbr[16], bbi[16];
#pragma unroll
    for (int c = 0; c < 16; ++c) { const float br = b_re[((size_t)dg * NP + p) * SG + c], bi = b_im[((size_t)dg * NP + p) * SG + c]; bbr[c] = r.cr * br - r.ci * bi; bbi[c] = r.cr * bi + r.ci * br; }
    float sr = 0.f, si = 0.f;
    for (int jj = 0; jj < T; ++jj) { const int j = ck * T + (dir ? T - 1 - jj : jj);
        float bur = 0.f, bui = 0.f;
#pragma unroll
        for (int c = 0; c < 16; ++c) { const float u = Uctx[(size_t)j * DS + g * SG + c]; bur += bbr[c] * u; bui += bbi[c] * u; }
        const float nsr = r.abr * sr - r.abi * si + bur, nsi = r.abr * si + r.abi * sr + bui; sr = nsr; si = nsi; }
    Ectx[(size_t)item * NP + p] = make_float2(sr, si);
}
__global__ void __launch_bounds__(64) k_ctx_state(const float* a_re, const float* a_im, const float* log_dt, const float* b_re, const float* b_im, const float* Uctx, float2* Ectx) {
    ctx_chunk_state(blockIdx.x, threadIdx.x, a_re, a_im, log_dt, b_re, b_im, Uctx, Ectx);
}
__device__ __forceinline__ void scan_item(int item, int tid, float2* Fs  , const float* a_re, const float* a_im, const float* log_dt, const float2* Ectx, const float* E, h16* Uext) {
    const int ph = item & 1, dir = (item >> 1) & 1, g = item >> 2, dg = dir * NG + g, seg = tid >> 5, pl = tid & 31, p = ph * 32 + pl;
    const SsmPar r = ssm_par(a_re, a_im, log_dt, dg, p);
    float2 aT = make_float2(r.abr, r.abi);
#pragma unroll
    for (int q = 0; q < 5; ++q) aT = cmul(aT, aT);
    float2 aS = aT;
#pragma unroll
    for (int q = 0; q < 5; ++q) aS = cmul(aS, aS);
    float2 e[32];
#pragma unroll
    for (int kk = 0; kk < 32; ++kk) { const int q = seg * 32 + kk, k = dir ? NC - 1 - q : q; e[kk] = *(const float2*)(E + ((size_t)g * NC + k) * 256 + dir * 128 + 2 * p); }
    float2 f = make_float2(0.f, 0.f);
#pragma unroll
    for (int kk = 0; kk < 32; ++kk) { const float2 t = cmul(aT, f); f = make_float2(t.x + e[kk].x, t.y + e[kk].y); }
    __syncthreads();
    Fs[seg * 32 + pl] = f;
    float2 st = make_float2(0.f, 0.f);
#pragma unroll
    for (int kk = 0; kk < 8; ++kk) { const int k = dir ? 7 - kk : kk; const float2 ec = Ectx[((size_t)(dir * NG + g) * 8 + k) * NP + p]; const float2 t = cmul(aT, st); st = make_float2(t.x + ec.x, t.y + ec.y); }
    __syncthreads();
    for (int s2 = 0; s2 < seg; ++s2) { const float2 t = cmul(aS, st), fs = Fs[s2 * 32 + pl]; st = make_float2(t.x + fs.x, t.y + fs.y); }
#pragma unroll
    for (int kk = 0; kk < 32; ++kk) { const int q = seg * 32 + kk, k = dir ? NC - 1 - q : q;
        *(unsigned*)(Uext + ((size_t)g * NC + k) * KY + 512 + dir * 128 + 2 * p) = f2bf(st.x) | (f2bf(st.y) << 16);
        const float2 t = cmul(aT, st); st = make_float2(t.x + e[kk].x, t.y + e[kk].y); }
}
__global__ void __launch_bounds__(512) k_scan(const float* a_re, const float* a_im, const float* log_dt, const float2* Ectx, const float* E, h16* Uext) {
    __shared__ float2 Fs[512];
    scan_item(blockIdx.x, threadIdx.x, Fs, a_re, a_im, log_dt, Ectx, E, Uext);
}

__global__ void __launch_bounds__(256) k_epi_ffn(const float* Z, int row0, h16* ACT) {
    const int m = blockIdx.x; const float* z = Z + (size_t)m * (2 * DFF);
    for (int j = threadIdx.x; j < DFF; j += 256) { const int q = j >> 7, lc = j & 127; const float gt = z[256 * q + lc], up = z[256 * q + 128 + lc];
        ACT[(size_t)(row0 + m) * DFF + j] = (h16)f2bf(siluf_(gt) * up); }
}
__global__ void __launch_bounds__(256) k_final(float* X, const float* fg) {
    __shared__ float red[8];
    const int m = blockIdx.x; float* xr = X + (size_t)m * D;
    float v[4]; float ss = 0.f;
    for (int i = 0; i < 4; ++i) { v[i] = xr[threadIdx.x + 256 * i]; ss += v[i] * v[i]; }
    const float rstd = rsqrtf(block_sum(ss, red) * (1.f / D) + EPS);
    for (int i = 0; i < 4; ++i) { const int k = threadIdx.x + 256 * i; xr[k] = v[i] * rstd * fg[k]; }
}


namespace pg8 {
#define PG8_LAS __attribute__((address_space(3)))
typedef short bf16x8 __attribute__((ext_vector_type(8)));
typedef float f32x4 __attribute__((ext_vector_type(4)));
typedef unsigned u32x4 __attribute__((ext_vector_type(4)));
constexpr int BM = 256, BK = 64, HALF = 128, HTB = HALF * BK * 2, STAGE_BYTES = 8 * HTB, NXCD = 8, WGM = 8;
__host__ __device__ __forceinline__ int lds_byte(int r, int c) { const int st = (r >> 4) * 2 + (c >> 5), rr = r & 15, cc = c & 31, ob = rr * 64 + cc * 2; return st * 1024 + (ob ^ (((ob >> 9) & 1) << 5)); }
__host__ __device__ __forceinline__ void stage_rc(int b, int& R, int& C) { const int st = b / 1024, sb = b % 1024, swz = sb ^ (((sb >> 9) & 1) << 5); R = (st >> 1) * 16 + swz / 64; C = (st & 1) * 32 + (swz % 64) / 2; }
__host__ __device__ __forceinline__ int perm32(int rho) { const int n = rho >> 4, i = rho & 15; return 8 * (i >> 2) + 4 * n + (i & 3); }
struct Unit { int pm, pn, z; };
struct Gemm { const char* A; const char* Bt; long a_rs, a_kbs, a_bs, b_rs, b_bs, K; };
struct StaticOrder {
    int nM, nN, nwg, G, c, extra;
    __host__ __device__ void init(int M, int N, int G_, int c_) { nM = M / BM; nN = N / BM; nwg = nM * nN; G = G_; c = c_; extra = 0; }
    __host__ __device__ bool next(int i, Unit& u) const {
        const long Lx = (long)i * G + c; if (Lx >= nwg + extra) return false;
        u.z = 0;
        if (Lx >= nwg) { u.pm = nM; u.pn = nN - extra + (int)(Lx - nwg); return true; }
        int wgid = (int)Lx; { const int q = nwg / NXCD, r = nwg % NXCD, xcd = wgid % NXCD, off = wgid / NXCD; wgid = (xcd < r ? xcd * (q + 1) : r * (q + 1) + (xcd - r) * q) + off; }
        const int nig = WGM * nN, gid = wgid / nig, fm = gid * WGM, gsz = (nM - fm) < WGM ? (nM - fm) : WGM;
        u.pm = fm + ((wgid % nig) % gsz); u.pn = (wgid % nig) / gsz; return true;
    }
    __device__ __forceinline__ void a_ready(const Unit&) const {}
    __device__ __forceinline__ void done(const Unit&) const {}
};
struct BatchOrder {
    int nun, upn, upb, G, c, pad;
    __host__ __device__ void init(int nb, int upm_, int upn_, int G_, int c_) { upn = upn_; upb = upm_ * upn_; nun = nb * upb; G = G_; c = c_; pad = 0; }
    __host__ __device__ bool next(int i, Unit& u) const {
        if (i != 0 || c >= nun) return false;
        const int wgid = (c % NXCD) * (nun / NXCD) + c / NXCD;
        u.z = wgid / upb; const int r = wgid % upb; u.pm = r / upn; u.pn = r % upn; return true;
    }
    __device__ __forceinline__ void a_ready(const Unit&) const {}
    __device__ __forceinline__ void done(const Unit&) const {}
};
__device__ __forceinline__ unsigned cvt_pk_bf16(float lo, float hi) { unsigned r; asm volatile("v_cvt_pk_bf16_f32 %0, %1, %2" : "=v"(r) : "v"(lo), "v"(hi)); return r; }
__device__ __forceinline__ float fsig(float x) { return __builtin_amdgcn_rcpf(1.f + __expf(-x)); }
__device__ __forceinline__ u32x4 pack8(const f32x4& a, const f32x4& b) { u32x4 w; w.x = cvt_pk_bf16(a[0], a[1]); w.y = cvt_pk_bf16(a[2], a[3]); w.z = cvt_pk_bf16(b[0], b[1]); w.w = cvt_pk_bf16(b[2], b[3]); return w; }
__device__ __forceinline__ void unpack8(const u32x4& w, f32x4& a, f32x4& b) {
    a[0] = __uint_as_float(w.x << 16); a[1] = __uint_as_float(w.x & 0xffff0000u); a[2] = __uint_as_float(w.y << 16); a[3] = __uint_as_float(w.y & 0xffff0000u);
    b[0] = __uint_as_float(w.z << 16); b[1] = __uint_as_float(w.z & 0xffff0000u); b[2] = __uint_as_float(w.w << 16); b[3] = __uint_as_float(w.w & 0xffff0000u); }

struct EpiG1 {
    static constexpr bool PERM = true, AFTER_DRAIN = false;
    h16* Aconv; h16* Uext; float* Uctx;
    __device__ __forceinline__ void operator()(const f32x4 (&acc)[2][2][4][2], const Unit& u, int wr, int wc, int fr, int fq) const {
        const int row0 = u.pm * BM + wr * 64 + fr;
        if (u.pn < 4) {
            const int ch0 = u.pn * 128 + wc * 32 + 8 * fq;
#pragma unroll
            for (int ai = 0; ai < 2; ++ai)
#pragma unroll
                for (int m = 0; m < 4; ++m) { const int row = row0 + ai * HALF + m * 16; f32x4 o0, o1;
#pragma unroll
                    for (int j = 0; j < 4; ++j) { o0[j] = acc[ai][0][m][0][j] * fsig(acc[ai][1][m][0][j]); o1[j] = acc[ai][0][m][1][j] * fsig(acc[ai][1][m][1][j]); }
                    *(u32x4*)(Aconv + (size_t)row * DC + ch0) = pack8(o0, o1); }
        } else {
#pragma unroll
            for (int ai = 0; ai < 2; ++ai)
#pragma unroll
                for (int m = 0; m < 4; ++m) { const int row = row0 + ai * HALF + m * 16;
#pragma unroll
                    for (int bj = 0; bj < 2; ++bj) { const int chs = (u.pn - 4) * 256 + bj * HALF + wc * 32 + 8 * fq;
                        if (u.pm < L / BM) *(u32x4*)(Uext + ((size_t)(chs >> 4) * NC + (row >> 5)) * KY + (row & 31) * SG + (chs & 15)) = pack8(acc[ai][bj][m][0], acc[ai][bj][m][1]);
                        else { float* p = Uctx + (size_t)(row - L) * DS + chs; *(f32x4*)p = acc[ai][bj][m][0]; *(f32x4*)(p + 4) = acc[ai][bj][m][1]; } } }
        }
    }
};
struct EpiGluF {
    static constexpr bool PERM = true, AFTER_DRAIN = false;
    const h16* Gact; const float* b_glu; h16* MIX;
    __device__ __forceinline__ void operator()(const f32x4 (&acc)[2][2][4][2], const Unit& u, int wr, int wc, int fr, int fq) const {
        const int row0 = u.pm * BM + wr * 64 + fr, col0 = u.pn * BM + wc * 32 + 8 * fq;
        f32x4 bv[2][2];
#pragma unroll
        for (int bj = 0; bj < 2; ++bj)
#pragma unroll
            for (int n = 0; n < 2; ++n) bv[bj][n] = *(const f32x4*)(b_glu + col0 + bj * HALF + 4 * n);
#pragma unroll
        for (int ai = 0; ai < 2; ++ai)
#pragma unroll
            for (int m = 0; m < 4; ++m) { const int row = row0 + ai * HALF + m * 16;
#pragma unroll
                for (int bj = 0; bj < 2; ++bj) { const int col = col0 + bj * HALF;
                    const u32x4 gw = *(const u32x4*)(Gact + (size_t)(col >> 4) * (L * 16) + (size_t)row * 16 + (col & 15)); f32x4 g0, g1; unpack8(gw, g0, g1);
                    const f32x4 v0 = acc[ai][bj][m][0] + bv[bj][0], v1 = acc[ai][bj][m][1] + bv[bj][1]; f32x4 o0, o1;
#pragma unroll
                    for (int j = 0; j < 4; ++j) { o0[j] = g0[j] * fsig(v0[j]); o1[j] = g1[j] * fsig(v1[j]); }
                    *(u32x4*)(MIX + (size_t)row * 1024 + 512 + col) = pack8(o0, o1); } }
    }
};
struct EpiResF {
    static constexpr bool PERM = false, AFTER_DRAIN = false;
    const float* base; const float* gate; float* out;
    __device__ __forceinline__ void operator()(const f32x4 (&acc)[2][2][4][2], const Unit& u, int wr, int wc, int fr, int fq) const {
        const int row0 = u.pm * BM + wr * 64 + fr, col0 = u.pn * BM + wc * 32 + 4 * fq;
        f32x4 gv[2][2];
#pragma unroll
        for (int bj = 0; bj < 2; ++bj)
#pragma unroll
            for (int n = 0; n < 2; ++n) gv[bj][n] = *(const f32x4*)(gate + col0 + bj * HALF + n * 16);
#pragma unroll
        for (int ai = 0; ai < 2; ++ai)
#pragma unroll
            for (int m = 0; m < 4; ++m) { const size_t off = (size_t)(row0 + ai * HALF + m * 16) * D + col0;
#pragma unroll
                for (int bj = 0; bj < 2; ++bj)
#pragma unroll
                    for (int n = 0; n < 2; ++n) { const f32x4 b = *(const f32x4*)(base + off + bj * HALF + n * 16); *(f32x4*)(out + off + bj * HALF + n * 16) = b + gv[bj][n] * acc[ai][bj][m][n]; } }
    }
};
struct EpiFfn {
    static constexpr bool PERM = true, AFTER_DRAIN = false;
    h16* ACT; long pad;
    __device__ __forceinline__ void operator()(const f32x4 (&acc)[2][2][4][2], const Unit& u, int wr, int wc, int fr, int fq) const {
        const int row0 = u.pm * BM + wr * 64 + fr, ch0 = u.pn * 128 + wc * 32 + 8 * fq;
#pragma unroll
        for (int ai = 0; ai < 2; ++ai)
#pragma unroll
            for (int m = 0; m < 4; ++m) { const int row = row0 + ai * HALF + m * 16; f32x4 o0, o1;
#pragma unroll
                for (int j = 0; j < 4; ++j) { const float g0 = acc[ai][0][m][0][j], g1 = acc[ai][0][m][1][j]; o0[j] = g0 * fsig(g0) * acc[ai][1][m][0][j]; o1[j] = g1 * fsig(g1) * acc[ai][1][m][1][j]; }
                *(u32x4*)(ACT + (size_t)row * DFF + ch0) = pack8(o0, o1); }
    }
};
struct EpiE {
    static constexpr bool PERM = false, AFTER_DRAIN = false;
    float* E; long pad;
    __device__ __forceinline__ void operator()(const f32x4 (&acc)[2][2][4][2], const Unit& u, int wr, int wc, int fr, int fq) const {
        const int row0 = u.pm * BM + wr * 64 + fr, col0 = u.pn * BM + wc * 32 + 4 * fq;
#pragma unroll
        for (int ai = 0; ai < 2; ++ai)
#pragma unroll
            for (int m = 0; m < 4; ++m) { float* rowp = E + ((size_t)u.z * NC + row0 + ai * HALF + m * 16) * 256 + col0;
#pragma unroll
                for (int bj = 0; bj < 2; ++bj)
#pragma unroll
                    for (int n = 0; n < 2; ++n) *(f32x4*)(rowp + bj * HALF + n * 16) = acc[ai][bj][m][n]; }
    }
};
__device__ __forceinline__ float gelu_t(float x) {
    const float u2 = 1.5957691216057308f * (x + 0.044715f * x * x * x); return x * fsig(u2); }
struct EpiY {
    static constexpr bool PERM = true, AFTER_DRAIN = false;
    h16* Gact; long pad;
    __device__ __forceinline__ void operator()(const f32x4 (&acc)[2][2][4][2], const Unit& u, int wr, int wc, int fr, int fq) const {
        const int row0 = u.pm * BM + wr * 64 + fr, col0 = u.pn * BM + wc * 32 + 8 * fq;
#pragma unroll
        for (int ai = 0; ai < 2; ++ai)
#pragma unroll
            for (int m = 0; m < 4; ++m) { const int k = row0 + ai * HALF + m * 16;
#pragma unroll
                for (int bj = 0; bj < 2; ++bj) { const int col = col0 + bj * HALF, t = k * T + (col >> 4); f32x4 o0, o1;
#pragma unroll
                    for (int j = 0; j < 4; ++j) { o0[j] = gelu_t(acc[ai][bj][m][0][j]); o1[j] = gelu_t(acc[ai][bj][m][1][j]); }
                    *(u32x4*)(Gact + (size_t)u.z * (L * 16) + (size_t)t * 16 + (col & 15)) = pack8(o0, o1); } }
    }
};

template <class Epi, class Sched, bool ALIGN_EPI = false, bool SP2 = false>
__device__ __forceinline__ void gemm_phase(PG8_LAS unsigned char* lds, const Gemm g, const Sched& S, const Epi& E) {
    const int tid = threadIdx.x, wid = __builtin_amdgcn_readfirstlane(tid >> 6), lane = tid & 63, wr = wid >> 2, wc = wid & 3, fr = lane & 15, fq = lane >> 4;
    const int nt = g.K / BK;
    unsigned voffA[2], voffB[2];
#pragma unroll
    for (int i = 0; i < 2; ++i) { int R, C; stage_rc(tid * 16 + i * 8192, R, C); const int Rb = Epi::PERM ? ((R & ~31) + perm32(R & 31)) : R;
        voffA[i] = (unsigned)((long)R * g.a_rs + (long)(C >> 4) * g.a_kbs + (C & 15) * 2); voffB[i] = (unsigned)((long)Rb * g.b_rs + C * 2); }
    const size_t kstepA = (size_t)(4 * g.a_kbs), kstepB = (size_t)(BK * 2);
    const size_t hstepA = (size_t)HALF * g.a_rs, hstepB = (size_t)HALF * g.b_rs;
    const size_t tstepA = 2 * hstepA, tstepB = 2 * hstepB;
    const unsigned ldsw = (unsigned)wid * 1024u;
    const int aoff = lds_byte(wr * 64 + fr, fq * 8), boff = lds_byte(wc * 32 + fr, fq * 8);
#define PG8_SA(b, h) (((b) * 2 + (h)) * HTB)
#define PG8_SB(b, h) ((4 + (b) * 2 + (h)) * HTB)
#define PG8_STAGE(bufoff, gbase, voff) do { _Pragma("unroll") for (int _i = 0; _i < 2; ++_i) \
        __builtin_amdgcn_global_load_lds((const unsigned*)((const char*)(gbase) + (voff)[_i]), (PG8_LAS unsigned*)(lds + (bufoff) + ldsw + _i * 8192), 16, 0, 0); } while (0)
#define PG8_LDA(dst, b, h) do { _Pragma("unroll") for (int m = 0; m < 4; ++m) _Pragma("unroll") for (int k = 0; k < 2; ++k) dst[m][k] = *(const PG8_LAS bf16x8*)(lds + PG8_SA(b, h) + aoff + m * 2048 + k * 1024); } while (0)
#define PG8_LDB(dst, b, h) do { _Pragma("unroll") for (int n = 0; n < 2; ++n) _Pragma("unroll") for (int k = 0; k < 2; ++k) dst[n][k] = *(const PG8_LAS bf16x8*)(lds + PG8_SB(b, h) + boff + n * 2048 + k * 1024); } while (0)
#define PG8_MMA(ai, bj, At, Bt) do { __builtin_amdgcn_s_setprio(1); _Pragma("unroll") for (int m = 0; m < 4; ++m) _Pragma("unroll") for (int n = 0; n < 2; ++n) _Pragma("unroll") for (int k = 0; k < 2; ++k) \
        acc[ai][bj][m][n] = __builtin_amdgcn_mfma_f32_16x16x32_bf16(Bt[n][k], At[m][k], acc[ai][bj][m][n], 0, 0, 0); __builtin_amdgcn_s_setprio(0); } while (0)
#define PG8_WAIT_V(n) asm volatile("s_waitcnt vmcnt(" #n ")" ::: "memory")
#define PG8_WAIT_L(n) asm volatile("s_waitcnt lgkmcnt(" #n ")" ::: "memory")
#define PG8_BAR __builtin_amdgcn_s_barrier()
#define PG8_SCHED __builtin_amdgcn_sched_barrier(0)
    Unit cur, nxt; int ui = 0;
    if (!S.next(0, cur)) return;
    f32x4 acc[2][2][4][2];
#pragma unroll
    for (int a = 0; a < 2; ++a)
#pragma unroll
        for (int b = 0; b < 2; ++b)
#pragma unroll
            for (int m = 0; m < 4; ++m)
#pragma unroll
                for (int n = 0; n < 2; ++n) acc[a][b][m][n] = (f32x4){0.f, 0.f, 0.f, 0.f};
    bf16x8 At[4][2], B0[2][2], B1[2][2];
    const char* cA = g.A + (size_t)cur.z * g.a_bs + (size_t)cur.pm * tstepA; const char* cB = g.Bt + (size_t)cur.z * g.b_bs + (size_t)cur.pn * tstepB;
    S.a_ready(cur);
    if constexpr (SP2) {
        PG8_STAGE(PG8_SB(0, 0), cB, voffB); PG8_STAGE(PG8_SB(0, 1), cB + hstepB, voffB); PG8_STAGE(PG8_SA(0, 0), cA, voffA); PG8_STAGE(PG8_SA(0, 1), cA + hstepA, voffA);
        if (wr == 1) PG8_BAR;
        PG8_WAIT_V(2); PG8_BAR;
        PG8_STAGE(PG8_SB(1, 0), cB + kstepB, voffB); PG8_STAGE(PG8_SA(1, 0), cA + kstepA, voffA); PG8_STAGE(PG8_SB(1, 1), cB + hstepB + kstepB, voffB);
        PG8_WAIT_V(6); PG8_BAR;
    } else {
        PG8_STAGE(PG8_SB(0, 0), cB, voffB); PG8_STAGE(PG8_SA(0, 0), cA, voffA); PG8_STAGE(PG8_SB(0, 1), cB + hstepB, voffB); PG8_STAGE(PG8_SA(0, 1), cA + hstepA, voffA);
        if (wr == 1) PG8_BAR;
        PG8_WAIT_V(4); PG8_BAR;
        PG8_STAGE(PG8_SB(1, 0), cB + kstepB, voffB); PG8_STAGE(PG8_SA(1, 0), cA + kstepA, voffA); PG8_STAGE(PG8_SB(1, 1), cB + hstepB + kstepB, voffB);
        PG8_WAIT_V(6); PG8_BAR;
    }
    for (;;) {
        const bool has_next = S.next(ui + 1, nxt);
        const char* nA = has_next ? g.A + (size_t)nxt.z * g.a_bs + (size_t)nxt.pm * tstepA : cA; const char* nB = has_next ? g.Bt + (size_t)nxt.z * g.b_bs + (size_t)nxt.pn * tstepB : cB;
        for (int t = 0; t < nt; t += 2) {
            const bool last = (t == nt - 2);
            const char* a1 = cA + (size_t)(t + 1) * kstepA;
            const char* a2 = last ? nA : cA + (size_t)(t + 2) * kstepA; const char* b2 = last ? nB : cB + (size_t)(t + 2) * kstepB;
            const char* a3 = a2 + kstepA; const char* b3 = b2 + kstepB;
            if (last && has_next) S.a_ready(nxt);
            if constexpr (SP2) {
            PG8_LDB(B0, 0, 0); PG8_LDB(B1, 0, 1); PG8_SCHED; PG8_LDA(At, 0, 0); PG8_STAGE(PG8_SA(1, 1), a1 + hstepA, voffA);
            PG8_WAIT_V(8); PG8_WAIT_L(0); PG8_BAR; PG8_MMA(0, 0, At, B0); PG8_MMA(0, 1, At, B1); PG8_BAR; PG8_SCHED;
            PG8_LDA(At, 0, 1); PG8_STAGE(PG8_SB(0, 0), b2, voffB); PG8_STAGE(PG8_SB(0, 1), b2 + hstepB, voffB); PG8_STAGE(PG8_SA(0, 0), a2, voffA);
            PG8_WAIT_V(8); PG8_WAIT_L(0); PG8_BAR; PG8_MMA(1, 0, At, B0); PG8_MMA(1, 1, At, B1); PG8_BAR; PG8_SCHED;
            PG8_LDB(B0, 1, 0); PG8_LDB(B1, 1, 1); PG8_SCHED; PG8_LDA(At, 1, 0); PG8_STAGE(PG8_SA(0, 1), a2 + hstepA, voffA);
            PG8_WAIT_V(8); PG8_WAIT_L(0); PG8_BAR; PG8_MMA(0, 0, At, B0); PG8_MMA(0, 1, At, B1); PG8_BAR; PG8_SCHED;
            PG8_LDA(At, 1, 1); PG8_STAGE(PG8_SB(1, 0), b3, voffB); PG8_STAGE(PG8_SB(1, 1), b3 + hstepB, voffB); PG8_STAGE(PG8_SA(1, 0), a3, voffA);
            PG8_WAIT_V(8); PG8_WAIT_L(0); PG8_BAR; PG8_MMA(1, 0, At, B0); PG8_MMA(1, 1, At, B1); PG8_BAR; PG8_SCHED;
            } else {
            PG8_LDB(B0, 0, 0); PG8_SCHED; PG8_LDA(At, 0, 0); PG8_STAGE(PG8_SA(1, 1), a1 + hstepA, voffA);
            PG8_WAIT_L(8); PG8_BAR; PG8_WAIT_L(0); PG8_MMA(0, 0, At, B0); PG8_BAR; PG8_SCHED;
            PG8_LDB(B1, 0, 1); PG8_STAGE(PG8_SB(0, 0), b2, voffB);
            PG8_BAR; PG8_WAIT_L(0); PG8_MMA(0, 1, At, B1); PG8_BAR;
            PG8_LDA(At, 0, 1); PG8_STAGE(PG8_SA(0, 0), a2, voffA);
            PG8_BAR; PG8_WAIT_L(0); PG8_MMA(1, 0, At, B0); PG8_BAR; PG8_SCHED;
            PG8_STAGE(PG8_SB(0, 1), b2 + hstepB, voffB);
            PG8_WAIT_V(6); PG8_BAR; PG8_MMA(1, 1, At, B1); PG8_BAR;
            PG8_LDB(B0, 1, 0); PG8_SCHED; PG8_LDA(At, 1, 0); PG8_STAGE(PG8_SA(0, 1), a2 + hstepA, voffA);
            PG8_WAIT_L(8); PG8_BAR; PG8_WAIT_L(0); PG8_MMA(0, 0, At, B0); PG8_BAR; PG8_SCHED;
            PG8_LDB(B1, 1, 1); PG8_STAGE(PG8_SB(1, 0), b3, voffB);
            PG8_BAR; PG8_WAIT_L(0); PG8_MMA(0, 1, At, B1); PG8_BAR;
            PG8_LDA(At, 1, 1); PG8_STAGE(PG8_SA(1, 0), a3, voffA);
            PG8_BAR; PG8_WAIT_L(0); PG8_MMA(1, 0, At, B0); PG8_BAR; PG8_SCHED;
            PG8_STAGE(PG8_SB(1, 1), b3 + hstepB, voffB);
            PG8_WAIT_V(6); PG8_BAR; PG8_MMA(1, 1, At, B1); PG8_BAR;
            }
        }
        if constexpr (ALIGN_EPI) { if (wr == 0) PG8_BAR; }
        if constexpr (!Epi::AFTER_DRAIN) { E(acc, cur, wr, wc, fr, fq); S.done(cur); }
        if (!has_next) break;
#pragma unroll
        for (int a = 0; a < 2; ++a)
#pragma unroll
            for (int b = 0; b < 2; ++b)
#pragma unroll
                for (int m = 0; m < 4; ++m)
#pragma unroll
                    for (int n = 0; n < 2; ++n) acc[a][b][m][n] = (f32x4){0.f, 0.f, 0.f, 0.f};
        cur = nxt; cA = nA; cB = nB; ++ui;
        if constexpr (ALIGN_EPI) { if (wr == 1) PG8_BAR; }
    }
    PG8_WAIT_V(0);
    if constexpr (!ALIGN_EPI) { if (wr == 0) PG8_BAR; }
    PG8_BAR;
    if constexpr (Epi::AFTER_DRAIN) { E.fused(acc, cur, wr, wc, fr, fq, lds, wid, lane); S.done(cur); }
#undef PG8_SA
#undef PG8_SB
#undef PG8_STAGE
#undef PG8_LDA
#undef PG8_LDB
#undef PG8_MMA
#undef PG8_WAIT_V
#undef PG8_WAIT_L
#undef PG8_BAR
#undef PG8_SCHED
}
}

constexpr int FAST_LDS = 147456;
template <class Epi, class Sched, bool ALIGN, bool SP2>
__global__ void __launch_bounds__(512, 2) k_gemm_fast(pg8::Gemm g, Sched S, Epi E) {
    extern __shared__ __attribute__((aligned(16))) unsigned char lds[];
    Sched s = S; s.c = (int)blockIdx.x; s.G = (int)gridDim.x;
    pg8::gemm_phase<Epi, Sched, ALIGN, SP2>((PG8_LAS unsigned char*)lds, g, s, E);
}
template <class Epi, class Sched, bool ALIGN>
static void launch_fast(const pg8::Gemm& g, const Sched& S, const Epi& E, hipStream_t stream) {
    static bool attr = false;
    if (!attr) { (void)hipFuncSetAttribute((const void*)k_gemm_fast<Epi, Sched, ALIGN, true>, hipFuncAttributeMaxDynamicSharedMemorySize, FAST_LDS); attr = true; }
    hipLaunchKernelGGL((k_gemm_fast<Epi, Sched, ALIGN, true>), dim3(256), dim3(512), FAST_LDS, stream, g, S, E);
}

extern "C" void kernel_launch(void* const* d_in, const int* in_sizes, int n_in, void* d_out, int out_size, void* d_ws, size_t ws_size, hipStream_t stream) {
    const float* x = (const float*)d_in[0]; const float* c = (const float*)d_in[1]; const float* ctx = (const float*)d_in[2]; const float* c_ctx = (const float*)d_in[3];
    const float* w_mod = (const float*)d_in[4]; const float* b_mod = (const float*)d_in[5]; const float* norm1_g = (const float*)d_in[6]; const float* w_in = (const float*)d_in[7];
    const float* conv_w = (const float*)d_in[8]; const float* conv_b = (const float*)d_in[9]; const float* conv_ln_g = (const float*)d_in[10]; const float* conv_ln_b = (const float*)d_in[11];
    const float* a_re = (const float*)d_in[12]; const float* a_im = (const float*)d_in[13]; const float* log_dt = (const float*)d_in[14];
    const float* b_re = (const float*)d_in[15]; const float* b_im = (const float*)d_in[16]; const float* c_re = (const float*)d_in[17]; const float* c_im = (const float*)d_in[18];
    const float* ssm_d = (const float*)d_in[19]; const float* w_glu = (const float*)d_in[20]; const float* b_glu = (const float*)d_in[21]; const float* w_out = (const float*)d_in[22];
    const float* norm2_g = (const float*)d_in[23]; const float* w_gu = (const float*)d_in[24]; const float* w_dn = (const float*)d_in[25]; const float* fin_g = (const float*)d_in[26];
    unsigned char* ws = (unsigned char*)d_ws; float* out = (float*)d_out;
    if (n_in != 27 || ws_size < 256 * MiB) { fprintf(stderr, "kernel_launch: unexpected n_in %d / ws %zu\n", n_in, ws_size); return; }
    float* MOD = (float*)(ws + WS_MOD);
    h16* WinT = (h16*)(ws + WS_WIN); h16* WgluT = (h16*)(ws + WS_WGLU); h16* WoutT = (h16*)(ws + WS_WOUT); h16* WguT = (h16*)(ws + WS_WGU); h16* WdnT = (h16*)(ws + WS_WDN);
    h16* H = (h16*)(ws + WS_H); h16* Aconv = (h16*)(ws + WS_ACONV); h16* Uext = (h16*)(ws + WS_UEXT); float* Uctx = (float*)(ws + WS_UCTX);
    h16* ACT = (h16*)(ws + WS_ACT); h16* Gact = (h16*)(ws + WS_GACT); h16* MIX = (h16*)(ws + WS_MIX); h16* H2 = (h16*)(ws + WS_H2);
    float* ZTMP = (float*)(ws + WS_ZTMP); float* YDIR = (float*)(ws + WS_YDIR);
    float* KTAB = (float*)(ws + WS_KTAB); h16* WyT = (h16*)(ws + WS_WY); h16* PT = (h16*)(ws + WS_PT); float2* Ectx = (float2*)(ws + WS_ECTX); float* Ebuf = (float*)(ws + WS_E);

    k_mod<<<6 * D / 256, 256, 0, stream>>>(c, c_ctx, w_mod, b_mod, MOD);
    k_transpose<MapIn><<<dim3(DIN / 32, D / 32), 256, 0, stream>>>(w_in, D, DIN, WinT);
    k_transpose<MapId><<<dim3(DS / 32, DS / 32), 256, 0, stream>>>(w_glu, DS, DS, WgluT);
    k_transpose<MapId><<<dim3(D / 32, D / 32), 256, 0, stream>>>(w_out, D, D, WoutT);
    k_transpose<MapGu><<<dim3(2 * DFF / 32, D / 32), 256, 0, stream>>>(w_gu, D, 2 * DFF, WguT);
    k_transpose<MapId><<<dim3(D / 32, DFF / 32), 256, 0, stream>>>(w_dn, DFF, D, WdnT);
#if FAST_SSM
    k_ktab<<<256, 256, 0, stream>>>(a_re, a_im, log_dt, b_re, b_im, c_re, c_im, KTAB);
    k_ssm_mats<<<1024, 256, 0, stream>>>(a_re, a_im, log_dt, b_re, b_im, c_re, c_im, ssm_d, KTAB, WyT, PT);
#endif
    k_norm_mod<<<MR, 256, 0, stream>>>(x, ctx, L, norm1_g, MOD, 0, 1, H);
#if FAST_G1
    { pg8::Gemm g{(const char*)H, (const char*)WinT, 2 * D, 32, 0, 2 * D, 0, D}; pg8::StaticOrder S; S.init(L, DIN, 256, 0); S.extra = 2;
      pg8::EpiG1 E{Aconv, Uext, Uctx}; launch_fast<pg8::EpiG1, pg8::StaticOrder, true>(g, S, E, stream); }
#else
    { ADesc A{H, D, 0, 1 << 30, 0}; EpiStoreF32 E{ZTMP, DIN, 0, 0};
      k_gemm_simple<EpiStoreF32><<<dim3(DIN / 128, MR / 128, 1), 256, 0, stream>>>(A, WinT, D, 0, MR, DIN, D, E); }
    k_epi1<<<MR, 256, 0, stream>>>(ZTMP, Aconv, Uext, Uctx);
#endif
#if FAST_SSM
    k_ctx_state<<<2 * NG * 8, 64, 0, stream>>>(a_re, a_im, log_dt, b_re, b_im, Uctx, Ectx);
    { pg8::Gemm g{(const char*)Uext, (const char*)PT, 2 * KY, 32, (long)NC * KY * 2, 2 * 512, 256L * 512 * 2, 512}; pg8::BatchOrder S; S.init(NG, 2, 1, 256, 0);
      pg8::EpiE E{Ebuf, 0}; launch_fast<pg8::EpiE, pg8::BatchOrder, false>(g, S, E, stream); }
    k_scan<<<NG * 4, 512, 0, stream>>>(a_re, a_im, log_dt, Ectx, Ebuf, Uext);
    { pg8::Gemm g{(const char*)Uext, (const char*)WyT, 2 * KY, 32, (long)NC * KY * 2, 2 * KY, 512L * KY * 2, KY}; pg8::BatchOrder S; S.init(NG, 2, 2, 256, 0);
      pg8::EpiY E{Gact, 0}; launch_fast<pg8::EpiY, pg8::BatchOrder, false>(g, S, E, stream); }
#else
    k_ssm_naive<<<2 * NG, 64, 0, stream>>>(a_re, a_im, log_dt, b_re, b_im, c_re, c_im, Uext, Uctx, YDIR);
    k_ssm_fin<<<L, 256, 0, stream>>>(Uext, YDIR, ssm_d, Gact);
#endif
    k_conv<<<L, 512, 0, stream>>>(Aconv, conv_w, conv_b, conv_ln_g, conv_ln_b, MIX);
#if FAST_GLU
    { pg8::Gemm g{(const char*)Gact, (const char*)WgluT, 32, (long)L * 32, 0, 2 * DS, 0, DS}; pg8::StaticOrder S; S.init(L, DS, 256, 0);
      pg8::EpiGluF E{Gact, b_glu, MIX}; launch_fast<pg8::EpiGluF, pg8::StaticOrder, false>(g, S, E, stream); }
#else
    { ADesc A{Gact, 16, (long)L * 16, 16, 0}; EpiGlu E{Gact, b_glu, MIX};
      k_gemm_simple<EpiGlu><<<dim3(DS / 128, L / 128, 1), 256, 0, stream>>>(A, WgluT, DS, 0, L, DS, DS, E); }
#endif
#if FAST_OUT
    { pg8::Gemm g{(const char*)MIX, (const char*)WoutT, 2 * D, 32, 0, 2 * D, 0, D}; pg8::StaticOrder S; S.init(L, D, 256, 0);
      pg8::EpiResF E{x, MOD + 2 * D, out}; launch_fast<pg8::EpiResF, pg8::StaticOrder, false>(g, S, E, stream); }
#else
    { ADesc A{MIX, D, 0, 1 << 30, 0}; EpiOut E{x, MOD + 2 * D, out};
      k_gemm_simple<EpiOut><<<dim3(D / 128, L / 128, 1), 256, 0, stream>>>(A, WoutT, D, 0, L, D, D, E); }
#endif
    k_norm_mod<<<L, 256, 0, stream>>>(out, out, L, norm2_g, MOD, 3, 4, H2);
#if FAST_FFN
    { pg8::Gemm g{(const char*)H2, (const char*)WguT, 2 * D, 32, 0, 2 * D, 0, D}; pg8::StaticOrder S; S.init(L, 2 * DFF, 256, 0);
      pg8::EpiFfn E{ACT, 0}; launch_fast<pg8::EpiFfn, pg8::StaticOrder, true>(g, S, E, stream); }
    { pg8::Gemm g{(const char*)ACT, (const char*)WdnT, 2 * DFF, 32, 0, 2 * DFF, 0, DFF}; pg8::StaticOrder S; S.init(L, D, 256, 0);
      pg8::EpiResF E{out, MOD + 5 * D, out}; launch_fast<pg8::EpiResF, pg8::StaticOrder, false>(g, S, E, stream); }
#else
    constexpr int RCH = 2048;
    for (int r0 = 0; r0 < L; r0 += RCH) {
        ADesc A{H2 + (size_t)r0 * D, D, 0, 1 << 30, 0}; EpiStoreF32 E{ZTMP, 2 * DFF, 0, 0};
        k_gemm_simple<EpiStoreF32><<<dim3(2 * DFF / 128, RCH / 128, 1), 256, 0, stream>>>(A, WguT, D, 0, RCH, 2 * DFF, D, E);
        k_epi_ffn<<<RCH, 256, 0, stream>>>(ZTMP, r0, ACT);
    }
    { ADesc A{ACT, DFF, 0, 1 << 30, 0}; EpiDown E{MOD + 5 * D, out};
      k_gemm_simple<EpiDown><<<dim3(D / 128, L / 128, 1), 256, 0, stream>>>(A, WdnT, DFF, 0, L, D, DFF, E); }
#endif
    k_final<<<L, 256, 0, stream>>>(out, fin_g);
}
```

```cpp
#include <hip/hip_runtime.h>
#include <stdint.h>
#include <cstdio>

typedef unsigned short h16;
typedef unsigned u32x4g __attribute__((ext_vector_type(4)));
typedef unsigned u32x2g __attribute__((ext_vector_type(2)));
typedef float f32x2 __attribute__((ext_vector_type(2)));
typedef float f32x4 __attribute__((ext_vector_type(4)));
#define LAS __attribute__((address_space(3)))

namespace cfg {
constexpr int L = 16384, D = 1024, CTX = 256, MR = L + CTX;
constexpr int DC = 512, DS = 512, NG = 32, SG = 16, NP = 64, CW = 31, DFF = 2816, DIN = 1536;
constexpr int GW = 64, ROWS = 256;
constexpr int T = 32, NC = L / T, KY = SG * T + 256;
constexpr float EPS = 1e-6f;
constexpr size_t MiB = 1u << 20;
constexpr size_t WS_CTL = 0, CTL_ZERO_BYTES = 1 * MiB, WS_MOD = 1 * MiB;
constexpr size_t WS_WIN = 2 * MiB, WS_WGLU = 5 * MiB, WS_WOUT = 6 * MiB, WS_WGU = 8 * MiB, WS_WDN = 19 * MiB;
constexpr size_t WS_WY = 25 * MiB, WS_PT = 49 * MiB, WS_UCTX = 57 * MiB, WS_ECTX = 57 * MiB + 512 * 1024, WS_KTAB = 58 * MiB;
constexpr size_t WS_H = 60 * MiB, WS_ACONV = 93 * MiB, WS_UEXT = 109 * MiB, WS_E = 133 * MiB, WS_ACT = 60 * MiB;
constexpr size_t WS_GACT = 149 * MiB, WS_MIX = 165 * MiB, WS_H2 = 197 * MiB;
constexpr size_t WS_MODP = 230 * MiB, WS_SSQ = 231 * MiB, WS_END = 256 * MiB;
constexpr int CW_BAR = 4096;
constexpr int RING_BYTES = 131072, LDSCTL_OFF = RING_BYTES, MISC_OFF = LDSCTL_OFF + 320, LDS_BYTES = 147456;
}
using namespace cfg;

__device__ __forceinline__ unsigned f2bf(float f) { unsigned u = __float_as_uint(f); return (u + 0x7fffu + ((u >> 16) & 1u)) >> 16; }
__device__ __forceinline__ unsigned pk2(float lo, float hi) { return f2bf(lo) | (f2bf(hi) << 16); }
__device__ __forceinline__ float bf2f(h16 v) { return __uint_as_float(((unsigned)v) << 16); }
__device__ __forceinline__ float siluf_(float x) { return x / (1.f + __expf(-x)); }
__device__ __forceinline__ float wave_sum(float v) {
#pragma unroll
    for (int o = 1; o < 64; o <<= 1) v += __shfl_xor(v, o);
    return v;
}

struct SsmPar { float x, y, abr, abi, cr, ci; };
__device__ __forceinline__ SsmPar ssm_par(const float* a_re, const float* a_im, const float* log_dt, int dg, int p) {
    SsmPar r; const float are = a_re[dg * NP + p], aim = a_im[dg * NP + p], dt = expf(log_dt[dg]);
    r.x = are * dt; r.y = aim * dt;
    float sn, cs; sincosf(r.y, &sn, &cs);
    const float em1 = expm1f(r.x), shalf = sinf(0.5f * r.y);
    r.abr = (em1 + 1.f) * cs; r.abi = (em1 + 1.f) * sn;
    const float nr = em1 * cs - 2.f * shalf * shalf, ni = r.abi, den = are * are + aim * aim;
    r.cr = (nr * are + ni * aim) / den; r.ci = (ni * are - nr * aim) / den;
    return r;
}
__device__ __forceinline__ float2 cpow_n(const SsmPar& r, int n) { float sn, cs; sincosf((float)n * r.y, &sn, &cs); const float e = expf((float)n * r.x); return make_float2(e * cs, e * sn); }
__device__ __forceinline__ float2 cmul(float2 a, float2 b) { return make_float2(a.x * b.x - a.y * b.y, a.x * b.y + a.y * b.x); }

__device__ __forceinline__ void ktab_item(int item, int tid, LAS f32x2* Cs  , LAS f32x2* Bs  , LAS f32x2* Ap  ,
                                          const float* a_re, const float* a_im, const float* log_dt, const float* b_re, const float* b_im, const float* c_re, const float* c_im, float* KT) {
    const int dq = item & 3, dg2 = item >> 2, g = dg2 >> 1, dir = dg2 & 1, dg = dir * NG + g;
    __syncthreads();
    if (tid < 64) { const int p = tid; const SsmPar r = ssm_par(a_re, a_im, log_dt, dg, p);
#pragma unroll
        for (int c = 0; c < 16; ++c) { const float br = b_re[((size_t)dg * NP + p) * SG + c], bi = b_im[((size_t)dg * NP + p) * SG + c]; Bs[p * 16 + c] = (f32x2){r.cr * br - r.ci * bi, r.cr * bi + r.ci * br}; }
#pragma unroll
        for (int dd = 0; dd < 8; ++dd) { const float2 ap = cpow_n(r, 8 * dq + dd); Ap[dd * 64 + p] = (f32x2){ap.x, ap.y}; } }
    for (int e = tid; e < 1024; e += 512) { const int c = e >> 6, p = e & 63; Cs[c * 64 + p] = (f32x2){c_re[((size_t)dg * SG + c) * NP + p], c_im[((size_t)dg * SG + c) * NP + p]}; }
    __syncthreads();
    const int hh = tid >> 8, t2 = tid & 255, c = t2 >> 4, cp = t2 & 15;
    float acc[4];
#pragma unroll
    for (int dd = 0; dd < 4; ++dd) acc[dd] = 0.f;
    for (int p = 0; p < NP; ++p) { const f32x2 cc = Cs[c * 64 + p], bb = Bs[p * 16 + cp]; const float mx = cc.x * bb.x - cc.y * bb.y, my = cc.x * bb.y + cc.y * bb.x;
#pragma unroll
        for (int dd = 0; dd < 4; ++dd) { const f32x2 a = Ap[(4 * hh + dd) * 64 + p]; acc[dd] += mx * a.x - my * a.y; } }
#pragma unroll
    for (int dd = 0; dd < 4; ++dd) KT[(((size_t)g * 2 + dir) * T + 8 * dq + 4 * hh + dd) * 256 + t2] = acc[dd];
}
__device__ __forceinline__ void wy_toep(size_t idx, const float* KT, const float* dskip, h16* WyT) {
    const int j = idx & 31, c = (idx >> 5) & 15, i = (idx >> 9) & 31, g = (int)(idx >> 14);
    const int d = i - j, ad = d < 0 ? -d : d;
    const float* kf = KT + (((size_t)g * 2 + 0) * T + ad) * 256 + c * 16; const float* kr = KT + (((size_t)g * 2 + 1) * T + ad) * 256 + c * 16;
    float v[16];
#pragma unroll
    for (int q = 0; q < 16; ++q) { const float f = kf[q], r = kr[q]; v[q] = d > 0 ? f : (d < 0 ? r : f + r + (q == c ? dskip[g * SG + c] : 0.f)); }
    u32x4g w0, w1;
    w0.x = f2bf(v[0]) | (f2bf(v[1]) << 16); w0.y = f2bf(v[2]) | (f2bf(v[3]) << 16); w0.z = f2bf(v[4]) | (f2bf(v[5]) << 16); w0.w = f2bf(v[6]) | (f2bf(v[7]) << 16);
    w1.x = f2bf(v[8]) | (f2bf(v[9]) << 16); w1.y = f2bf(v[10]) | (f2bf(v[11]) << 16); w1.z = f2bf(v[12]) | (f2bf(v[13]) << 16); w1.w = f2bf(v[14]) | (f2bf(v[15]) << 16);
    u32x4g* o = (u32x4g*)(WyT + ((size_t)g * 512 + i * 16 + c) * KY + j * 16); o[0] = w0; o[1] = w1;
}
__device__ __forceinline__ void wy_q(size_t idx, const float* a_re, const float* a_im, const float* log_dt, const float* c_re, const float* c_im, h16* WyT) {
    const int p = idx & 63, dir = (idx >> 6) & 1, i = (idx >> 7) & 31, g = (int)(idx >> 12), dg = dir * NG + g;
    const SsmPar r = ssm_par(a_re, a_im, log_dt, dg, p);
    const float2 ap = cpow_n(r, dir == 0 ? i + 1 : T - i);
#pragma unroll
    for (int c = 0; c < 16; ++c) { const float2 cc = make_float2(c_re[((size_t)dg * SG + c) * NP + p], c_im[((size_t)dg * SG + c) * NP + p]); const float2 q = cmul(cc, ap);
        *(unsigned*)(WyT + ((size_t)g * 512 + i * 16 + c) * KY + 512 + dir * 128 + 2 * p) = f2bf(q.x) | (f2bf(-q.y) << 16); }
}
__device__ __forceinline__ void pt_fill(size_t idx, const float* a_re, const float* a_im, const float* log_dt, const float* b_re, const float* b_im, h16* PT) {
    const int j = idx & 31, p = (idx >> 5) & 63, dir = (idx >> 11) & 1, g = (int)(idx >> 12), dg = dir * NG + g;
    const SsmPar r = ssm_par(a_re, a_im, log_dt, dg, p);
    const float2 ap = cpow_n(r, dir == 0 ? T - 1 - j : j); const float2 co = cmul(ap, make_float2(r.cr, r.ci));
    float vr[16], vi[16];
#pragma unroll
    for (int c = 0; c < 16; ++c) { const float2 v = cmul(co, make_float2(b_re[((size_t)dg * NP + p) * SG + c], b_im[((size_t)dg * NP + p) * SG + c])); vr[c] = v.x; vi[c] = v.y; }
    u32x4g w;
    u32x4g* o = (u32x4g*)(PT + ((size_t)g * 256 + dir * 128 + 2 * p) * 512 + j * 16);
    w.x = f2bf(vr[0]) | (f2bf(vr[1]) << 16); w.y = f2bf(vr[2]) | (f2bf(vr[3]) << 16); w.z = f2bf(vr[4]) | (f2bf(vr[5]) << 16); w.w = f2bf(vr[6]) | (f2bf(vr[7]) << 16); o[0] = w;
    w.x = f2bf(vr[8]) | (f2bf(vr[9]) << 16); w.y = f2bf(vr[10]) | (f2bf(vr[11]) << 16); w.z = f2bf(vr[12]) | (f2bf(vr[13]) << 16); w.w = f2bf(vr[14]) | (f2bf(vr[15]) << 16); o[1] = w;
    o += 512 * 2 / 16;
    w.x = f2bf(vi[0]) | (f2bf(vi[1]) << 16); w.y = f2bf(vi[2]) | (f2bf(vi[3]) << 16); w.z = f2bf(vi[4]) | (f2bf(vi[5]) << 16); w.w = f2bf(vi[6]) | (f2bf(vi[7]) << 16); o[0] = w;
    w.x = f2bf(vi[8]) | (f2bf(vi[9]) << 16); w.y = f2bf(vi[10]) | (f2bf(vi[11]) << 16); w.z = f2bf(vi[12]) | (f2bf(vi[13]) << 16); w.w = f2bf(vi[14]) | (f2bf(vi[15]) << 16); o[1] = w;
}
__device__ __forceinline__ void ctx_chunk_state(int item, int p, const float* a_re, const float* a_im, const float* log_dt, const float* b_re, const float* b_im, const float* Uctx, float2* Ectx) {
    const int ck = item & 7, g = (item >> 3) & 31, dir = item >> 8, dg = dir * NG + g;
    const SsmPar r = ssm_par(a_re, a_im, log_dt, dg, p);
    float bbr[16], bbi[16];
#pragma unroll
    for (int c = 0; c < 16; ++c) { const float br = b_re[((size_t)dg * NP + p) * SG + c], bi = b_im[((size_t)dg * NP + p) * SG + c]; bbr[c] = r.cr * br - r.ci * bi; bbi[c] = r.cr * bi + r.ci * br; }
    float sr = 0.f, si = 0.f;
    for (int jj = 0; jj < T; ++jj) { const int j = ck * T + (dir ? T - 1 - jj : jj);
        float bur = 0.f, bui = 0.f;
#pragma unroll
        for (int c = 0; c < 16; ++c) { const float u = Uctx[(size_t)j * DS + g * SG + c]; bur += bbr[c] * u; bui += bbi[c] * u; }
        const float nsr = r.abr * sr - r.abi * si + bur, nsi = r.abr * si + r.abi * sr + bui; sr = nsr; si = nsi; }
    Ectx[(size_t)item * NP + p] = make_float2(sr, si);
}
__device__ __forceinline__ void scan_item(int item, int tid, LAS f32x2* Fs  , const float* a_re, const float* a_im, const float* log_dt, const float2* Ectx, const float* E, h16* Uext) {
    const int ph = item & 1, dir = (item >> 1) & 1, g = item >> 2, dg = dir * NG + g, seg = tid >> 5, pl = tid & 31, p = ph * 32 + pl;
    const SsmPar r = ssm_par(a_re, a_im, log_dt, dg, p);
    float2 aT = make_float2(r.abr, r.abi);
#pragma unroll
    for (int q = 0; q < 5; ++q) aT = cmul(aT, aT);
    float2 aS = aT;
#pragma unroll
    for (int q = 0; q < 5; ++q) aS = cmul(aS, aS);
    float2 e[32];
#pragma unroll
    for (int kk = 0; kk < 32; ++kk) { const int q = seg * 32 + kk, k = dir ? NC - 1 - q : q; e[kk] = *(const float2*)(E + ((size_t)g * NC + k) * 256 + dir * 128 + 2 * p); }
    float2 f = make_float2(0.f, 0.f);
#pragma unroll
    for (int kk = 0; kk < 32; ++kk) { const float2 t = cmul(aT, f); f = make_float2(t.x + e[kk].x, t.y + e[kk].y); }
    __syncthreads();
    Fs[seg * 32 + pl] = (f32x2){f.x, f.y};
    float2 st = make_float2(0.f, 0.f);
#pragma unroll
    for (int kk = 0; kk < 8; ++kk) { const int k = dir ? 7 - kk : kk; const float2 ec = Ectx[((size_t)(dir * NG + g) * 8 + k) * NP + p]; const float2 t = cmul(aT, st); st = make_float2(t.x + ec.x, t.y + ec.y); }
    __syncthreads();
    for (int s2 = 0; s2 < seg; ++s2) { const float2 t = cmul(aS, st); const f32x2 fs = Fs[s2 * 32 + pl]; st = make_float2(t.x + fs.x, t.y + fs.y); }
#pragma unroll
    for (int kk = 0; kk < 32; ++kk) { const int q = seg * 32 + kk, k = dir ? NC - 1 - q : q;
        *(unsigned*)(Uext + ((size_t)g * NC + k) * KY + 512 + dir * 128 + 2 * p) = f2bf(st.x) | (f2bf(st.y) << 16);
        const float2 t = cmul(aT, st); st = make_float2(t.x + e[kk].x, t.y + e[kk].y); }
}
namespace pg8 {
#define PG8_LAS LAS
typedef short bf16x8 __attribute__((ext_vector_type(8)));
typedef unsigned u32x4 __attribute__((ext_vector_type(4)));
constexpr int BM = 256, BK = 64, HALF = 128, HTB = HALF * BK * 2, STAGE_BYTES = 8 * HTB, NXCD = 8, WGM = 8;
__host__ __device__ __forceinline__ int lds_byte(int r, int c) { const int st = (r >> 4) * 2 + (c >> 5), rr = r & 15, cc = c & 31, ob = rr * 64 + cc * 2; return st * 1024 + (ob ^ (((ob >> 9) & 1) << 5)); }
__host__ __device__ __forceinline__ void stage_rc(int b, int& R, int& C) { const int st = b / 1024, sb = b % 1024, swz = sb ^ (((sb >> 9) & 1) << 5); R = (st >> 1) * 16 + swz / 64; C = (st & 1) * 32 + (swz % 64) / 2; }
__host__ __device__ __forceinline__ int perm32(int rho) { const int n = rho >> 4, i = rho & 15; return 8 * (i >> 2) + 4 * n + (i & 3); }
struct Unit { int pm, pn, z; };
struct Gemm { const char* A; const char* Bt; long a_rs, a_kbs, a_bs, b_rs, b_bs, K; };
struct StaticOrder {
    int nM, nN, nwg, G, c, extra;
    __host__ __device__ void init(int M, int N, int G_, int c_) { nM = M / BM; nN = N / BM; nwg = nM * nN; G = G_; c = c_; extra = 0; }
    __host__ __device__ bool next(int i, Unit& u) const {
        const long Lx = (long)i * G + c; if (Lx >= nwg + extra) return false;
        u.z = 0;
        if (Lx >= nwg) { u.pm = nM; u.pn = nN - extra + (int)(Lx - nwg); return true; }
        int wgid = (int)Lx; { const int q = nwg / NXCD, r = nwg % NXCD, xcd = wgid % NXCD, off = wgid / NXCD; wgid = (xcd < r ? xcd * (q + 1) : r * (q + 1) + (xcd - r) * q) + off; }
        const int nig = WGM * nN, gid = wgid / nig, fm = gid * WGM, gsz = (nM - fm) < WGM ? (nM - fm) : WGM;
        u.pm = fm + ((wgid % nig) % gsz); u.pn = (wgid % nig) / gsz; return true;
    }
    __device__ __forceinline__ void a_ready(const Unit&) const {}
    __device__ __forceinline__ void done(const Unit&) const {}
};
struct BatchOrder {
    int nun, upn, upb, G, c, pad;
    __host__ __device__ void init(int nb, int upm_, int upn_, int G_, int c_) { upn = upn_; upb = upm_ * upn_; nun = nb * upb; G = G_; c = c_; pad = 0; }
    __host__ __device__ bool next(int i, Unit& u) const {
        if (i != 0 || c >= nun) return false;
        const int wgid = (c % NXCD) * (nun / NXCD) + c / NXCD;
        u.z = wgid / upb; const int r = wgid % upb; u.pm = r / upn; u.pn = r % upn; return true;
    }
    __device__ __forceinline__ void a_ready(const Unit&) const {}
    __device__ __forceinline__ void done(const Unit&) const {}
};
__device__ __forceinline__ unsigned cvt_pk_bf16(float lo, float hi) { unsigned r; asm volatile("v_cvt_pk_bf16_f32 %0, %1, %2" : "=v"(r) : "v"(lo), "v"(hi)); return r; }
__device__ __forceinline__ float fsig(float x) { return __builtin_amdgcn_rcpf(1.f + __expf(-x)); }
__device__ __forceinline__ u32x4 pack8(const f32x4& a, const f32x4& b) { u32x4 w; w.x = cvt_pk_bf16(a[0], a[1]); w.y = cvt_pk_bf16(a[2], a[3]); w.z = cvt_pk_bf16(b[0], b[1]); w.w = cvt_pk_bf16(b[2], b[3]); return w; }
__device__ __forceinline__ void unpack8(const u32x4& w, f32x4& a, f32x4& b) {
    a[0] = __uint_as_float(w.x << 16); a[1] = __uint_as_float(w.x & 0xffff0000u); a[2] = __uint_as_float(w.y << 16); a[3] = __uint_as_float(w.y & 0xffff0000u);
    b[0] = __uint_as_float(w.z << 16); b[1] = __uint_as_float(w.z & 0xffff0000u); b[2] = __uint_as_float(w.w << 16); b[3] = __uint_as_float(w.w & 0xffff0000u); }

struct EpiG1 {
    static constexpr bool PERM = true, AFTER_DRAIN = false;
    h16* Aconv; h16* Uext; float* Uctx;
    __device__ __forceinline__ void operator()(const f32x4 (&acc)[2][2][4][2], const Unit& u, int wr, int wc, int fr, int fq) const {
        const int row0 = u.pm * BM + wr * 64 + fr;
        if (u.pn < 4) {
            const int ch0 = u.pn * 128 + wc * 32 + 8 * fq;
#pragma unroll
            for (int ai = 0; ai < 2; ++ai)
#pragma unroll
                for (int m = 0; m < 4; ++m) { const int row = row0 + ai * HALF + m * 16; f32x4 o0, o1;
#pragma unroll
                    for (int j = 0; j < 4; ++j) { o0[j] = acc[ai][0][m][0][j] * fsig(acc[ai][1][m][0][j]); o1[j] = acc[ai][0][m][1][j] * fsig(acc[ai][1][m][1][j]); }
                    *(u32x4*)(Aconv + (size_t)row * DC + ch0) = pack8(o0, o1); }
        } else {
#pragma unroll
            for (int ai = 0; ai < 2; ++ai)
#pragma unroll
                for (int m = 0; m < 4; ++m) { const int row = row0 + ai * HALF + m * 16;
#pragma unroll
                    for (int bj = 0; bj < 2; ++bj) { const int chs = (u.pn - 4) * 256 + bj * HALF + wc * 32 + 8 * fq;
                        if (u.pm < L / BM) *(u32x4*)(Uext + ((size_t)(chs >> 4) * NC + (row >> 5)) * KY + (row & 31) * SG + (chs & 15)) = pack8(acc[ai][bj][m][0], acc[ai][bj][m][1]);
                        else { float* p = Uctx + (size_t)(row - L) * DS + chs; *(f32x4*)p = acc[ai][bj][m][0]; *(f32x4*)(p + 4) = acc[ai][bj][m][1]; } } }
        }
    }
};
struct EpiGluF {
    static constexpr bool PERM = true, AFTER_DRAIN = false;
    const h16* Gact; const float* b_glu; h16* MIX;
    __device__ __forceinline__ void operator()(const f32x4 (&acc)[2][2][4][2], const Unit& u, int wr, int wc, int fr, int fq) const {
        const int row0 = u.pm * BM + wr * 64 + fr, col0 = u.pn * BM + wc * 32 + 8 * fq;
        f32x4 bv[2][2];
#pragma unroll
        for (int bj = 0; bj < 2; ++bj)
#pragma unroll
            for (int n = 0; n < 2; ++n) bv[bj][n] = *(const f32x4*)(b_glu + col0 + bj * HALF + 4 * n);
#pragma unroll
        for (int ai = 0; ai < 2; ++ai)
#pragma unroll
            for (int m = 0; m < 4; ++m) { const int row = row0 + ai * HALF + m * 16;
#pragma unroll
                for (int bj = 0; bj < 2; ++bj) { const int col = col0 + bj * HALF;
                    const u32x4 gw = *(const u32x4*)(Gact + (size_t)(col >> 4) * (L * 16) + (size_t)row * 16 + (col & 15)); f32x4 g0, g1; unpack8(gw, g0, g1);
                    const f32x4 v0 = acc[ai][bj][m][0] + bv[bj][0], v1 = acc[ai][bj][m][1] + bv[bj][1]; f32x4 o0, o1;
#pragma unroll
                    for (int j = 0; j < 4; ++j) { o0[j] = g0[j] * fsig(v0[j]); o1[j] = g1[j] * fsig(v1[j]); }
                    *(u32x4*)(MIX + (size_t)row * 1024 + 512 + col) = pack8(o0, o1); } }
    }
};
struct EpiResF {
    static constexpr bool PERM = false, AFTER_DRAIN = false;
    const float* base; const float* gate; float* out;
    __device__ __forceinline__ void operator()(const f32x4 (&acc)[2][2][4][2], const Unit& u, int wr, int wc, int fr, int fq) const {
        const int row0 = u.pm * BM + wr * 64 + fr, col0 = u.pn * BM + wc * 32 + 4 * fq;
        f32x4 gv[2][2];
#pragma unroll
        for (int bj = 0; bj < 2; ++bj)
#pragma unroll
            for (int n = 0; n < 2; ++n) gv[bj][n] = *(const f32x4*)(gate + col0 + bj * HALF + n * 16);
#pragma unroll
        for (int ai = 0; ai < 2; ++ai)
#pragma unroll
            for (int m = 0; m < 4; ++m) { const size_t off = (size_t)(row0 + ai * HALF + m * 16) * D + col0;
#pragma unroll
                for (int bj = 0; bj < 2; ++bj)
#pragma unroll
                    for (int n = 0; n < 2; ++n) { const f32x4 b = *(const f32x4*)(base + off + bj * HALF + n * 16); *(f32x4*)(out + off + bj * HALF + n * 16) = b + gv[bj][n] * acc[ai][bj][m][n]; } }
    }
};
struct EpiFfn {
    static constexpr bool PERM = true, AFTER_DRAIN = false;
    h16* ACT; long pad;
    __device__ __forceinline__ void operator()(const f32x4 (&acc)[2][2][4][2], const Unit& u, int wr, int wc, int fr, int fq) const {
        const int row0 = u.pm * BM + wr * 64 + fr, ch0 = u.pn * 128 + wc * 32 + 8 * fq;
#pragma unroll
        for (int ai = 0; ai < 2; ++ai)
#pragma unroll
            for (int m = 0; m < 4; ++m) { const int row = row0 + ai * HALF + m * 16; f32x4 o0, o1;
#pragma unroll
                for (int j = 0; j < 4; ++j) { const float g0 = acc[ai][0][m][0][j], g1 = acc[ai][0][m][1][j]; o0[j] = g0 * fsig(g0) * acc[ai][1][m][0][j]; o1[j] = g1 * fsig(g1) * acc[ai][1][m][1][j]; }
                *(u32x4*)(ACT + (size_t)row * DFF + ch0) = pack8(o0, o1); }
    }
};
struct EpiE {
    static constexpr bool PERM = false, AFTER_DRAIN = false;
    float* E; long pad;
    __device__ __forceinline__ void operator()(const f32x4 (&acc)[2][2][4][2], const Unit& u, int wr, int wc, int fr, int fq) const {
        const int row0 = u.pm * BM + wr * 64 + fr, col0 = u.pn * BM + wc * 32 + 4 * fq;
#pragma unroll
        for (int ai = 0; ai < 2; ++ai)
#pragma unroll
            for (int m = 0; m < 4; ++m) { float* rowp = E + ((size_t)u.z * NC + row0 + ai * HALF + m * 16) * 256 + col0;
#pragma unroll
                for (int bj = 0; bj < 2; ++bj)
#pragma unroll
                    for (int n = 0; n < 2; ++n) *(f32x4*)(rowp + bj * HALF + n * 16) = acc[ai][bj][m][n]; }
    }
};
__device__ __forceinline__ float gelu_t(float x) {
    const float u2 = 1.5957691216057308f * (x + 0.044715f * x * x * x); return x * fsig(u2); }
struct EpiY {
    static constexpr bool PERM = true, AFTER_DRAIN = false;
    h16* Gact; long pad;
    __device__ __forceinline__ void operator()(const f32x4 (&acc)[2][2][4][2], const Unit& u, int wr, int wc, int fr, int fq) const {
        const int row0 = u.pm * BM + wr * 64 + fr, col0 = u.pn * BM + wc * 32 + 8 * fq;
#pragma unroll
        for (int ai = 0; ai < 2; ++ai)
#pragma unroll
            for (int m = 0; m < 4; ++m) { const int k = row0 + ai * HALF + m * 16;
#pragma unroll
                for (int bj = 0; bj < 2; ++bj) { const int col = col0 + bj * HALF, t = k * T + (col >> 4); f32x4 o0, o1;
#pragma unroll
                    for (int j = 0; j < 4; ++j) { o0[j] = gelu_t(acc[ai][bj][m][0][j]); o1[j] = gelu_t(acc[ai][bj][m][1][j]); }
                    *(u32x4*)(Gact + (size_t)u.z * (L * 16) + (size_t)t * 16 + (col & 15)) = pack8(o0, o1); } }
    }
};

template <class Epi, class Sched, bool ALIGN_EPI = false, bool SP2 = false>
__device__ __forceinline__ void gemm_phase(PG8_LAS unsigned char* lds, const Gemm g, const Sched& S, const Epi& E) {
    const int tid = threadIdx.x, wid = __builtin_amdgcn_readfirstlane(tid >> 6), lane = tid & 63, wr = wid >> 2, wc = wid & 3, fr = lane & 15, fq = lane >> 4;
    const int nt = g.K / BK;
    unsigned voffA[2], voffB[2];
#pragma unroll
    for (int i = 0; i < 2; ++i) { int R, C; stage_rc(tid * 16 + i * 8192, R, C); const int Rb = Epi::PERM ? ((R & ~31) + perm32(R & 31)) : R;
        voffA[i] = (unsigned)((long)R * g.a_rs + (long)(C >> 4) * g.a_kbs + (C & 15) * 2); voffB[i] = (unsigned)((long)Rb * g.b_rs + C * 2); }
    const size_t kstepA = (size_t)(4 * g.a_kbs), kstepB = (size_t)(BK * 2);
    const size_t hstepA = (size_t)HALF * g.a_rs, hstepB = (size_t)HALF * g.b_rs;
    const size_t tstepA = 2 * hstepA, tstepB = 2 * hstepB;
    const unsigned ldsw = (unsigned)wid * 1024u;
    const int aoff = lds_byte(wr * 64 + fr, fq * 8), boff = lds_byte(wc * 32 + fr, fq * 8);
#define PG8_SA(b, h) (((b) * 2 + (h)) * HTB)
#define PG8_SB(b, h) ((4 + (b) * 2 + (h)) * HTB)
#define PG8_STAGE(bufoff, gbase, voff) do { _Pragma("unroll") for (int _i = 0; _i < 2; ++_i) \
        __builtin_amdgcn_global_load_lds((const unsigned*)((const char*)(gbase) + (voff)[_i]), (PG8_LAS unsigned*)(lds + (bufoff) + ldsw + _i * 8192), 16, 0, 0); } while (0)
#define PG8_LDA(dst, b, h) do { _Pragma("unroll") for (int m = 0; m < 4; ++m) _Pragma("unroll") for (int k = 0; k < 2; ++k) dst[m][k] = *(const PG8_LAS bf16x8*)(lds + PG8_SA(b, h) + aoff + m * 2048 + k * 1024); } while (0)
#define PG8_LDB(dst, b, h) do { _Pragma("unroll") for (int n = 0; n < 2; ++n) _Pragma("unroll") for (int k = 0; k < 2; ++k) dst[n][k] = *(const PG8_LAS bf16x8*)(lds + PG8_SB(b, h) + boff + n * 2048 + k * 1024); } while (0)
#define PG8_MMA(ai, bj, At, Bt) do { __builtin_amdgcn_s_setprio(1); _Pragma("unroll") for (int m = 0; m < 4; ++m) _Pragma("unroll") for (int n = 0; n < 2; ++n) _Pragma("unroll") for (int k = 0; k < 2; ++k) \
        acc[ai][bj][m][n] = __builtin_amdgcn_mfma_f32_16x16x32_bf16(Bt[n][k], At[m][k], acc[ai][bj][m][n], 0, 0, 0); __builtin_amdgcn_s_setprio(0); } while (0)
#define PG8_WAIT_V(n) asm volatile("s_waitcnt vmcnt(" #n ")" ::: "memory")
#define PG8_WAIT_L(n) asm volatile("s_waitcnt lgkmcnt(" #n ")" ::: "memory")
#define PG8_BAR __builtin_amdgcn_s_barrier()
#define PG8_SCHED __builtin_amdgcn_sched_barrier(0)
    Unit cur, nxt; int ui = 0;
    if (!S.next(0, cur)) return;
    f32x4 acc[2][2][4][2];
#pragma unroll
    for (int a = 0; a < 2; ++a)
#pragma unroll
        for (int b = 0; b < 2; ++b)
#pragma unroll
            for (int m = 0; m < 4; ++m)
#pragma unroll
                for (int n = 0; n < 2; ++n) acc[a][b][m][n] = (f32x4){0.f, 0.f, 0.f, 0.f};
    bf16x8 At[4][2], B0[2][2], B1[2][2];
    const char* cA = g.A + (size_t)cur.z * g.a_bs + (size_t)cur.pm * tstepA; const char* cB = g.Bt + (size_t)cur.z * g.b_bs + (size_t)cur.pn * tstepB;
    S.a_ready(cur);
    if constexpr (SP2) {
        PG8_STAGE(PG8_SB(0, 0), cB, voffB); PG8_STAGE(PG8_SB(0, 1), cB + hstepB, voffB); PG8_STAGE(PG8_SA(0, 0), cA, voffA); PG8_STAGE(PG8_SA(0, 1), cA + hstepA, voffA);
        if (wr == 1) PG8_BAR;
        PG8_WAIT_V(2); PG8_BAR;
        PG8_STAGE(PG8_SB(1, 0), cB + kstepB, voffB); PG8_STAGE(PG8_SA(1, 0), cA + kstepA, voffA); PG8_STAGE(PG8_SB(1, 1), cB + hstepB + kstepB, voffB);
        PG8_WAIT_V(6); PG8_BAR;
    } else {
        PG8_STAGE(PG8_SB(0, 0), cB, voffB); PG8_STAGE(PG8_SA(0, 0), cA, voffA); PG8_STAGE(PG8_SB(0, 1), cB + hstepB, voffB); PG8_STAGE(PG8_SA(0, 1), cA + hstepA, voffA);
        if (wr == 1) PG8_BAR;
        PG8_WAIT_V(4); PG8_BAR;
        PG8_STAGE(PG8_SB(1, 0), cB + kstepB, voffB); PG8_STAGE(PG8_SA(1, 0), cA + kstepA, voffA); PG8_STAGE(PG8_SB(1, 1), cB + hstepB + kstepB, voffB);
        PG8_WAIT_V(6); PG8_BAR;
    }
    for (;;) {
        const bool has_next = S.next(ui + 1, nxt);
        const char* nA = has_next ? g.A + (size_t)nxt.z * g.a_bs + (size_t)nxt.pm * tstepA : cA; const char* nB = has_next ? g.Bt + (size_t)nxt.z * g.b_bs + (size_t)nxt.pn * tstepB : cB;
        for (int t = 0; t < nt; t += 2) {
            const bool last = (t == nt - 2);
            const char* a1 = cA + (size_t)(t + 1) * kstepA;
            const char* a2 = last ? nA : cA + (size_t)(t + 2) * kstepA; const char* b2 = last ? nB : cB + (size_t)(t + 2) * kstepB;
            const char* a3 = a2 + kstepA; const char* b3 = b2 + kstepB;
            if (last && has_next) S.a_ready(nxt);
            if constexpr (SP2) {
            PG8_LDB(B0, 0, 0); PG8_LDB(B1, 0, 1); PG8_SCHED; PG8_LDA(At, 0, 0); PG8_STAGE(PG8_SA(1, 1), a1 + hstepA, voffA);
            PG8_WAIT_V(8); PG8_WAIT_L(0); PG8_BAR; PG8_MMA(0, 0, At, B0); PG8_MMA(0, 1, At, B1); PG8_BAR; PG8_SCHED;
            PG8_LDA(At, 0, 1); PG8_STAGE(PG8_SB(0, 0), b2, voffB); PG8_STAGE(PG8_SB(0, 1), b2 + hstepB, voffB); PG8_STAGE(PG8_SA(0, 0), a2, voffA);
            PG8_WAIT_V(8); PG8_WAIT_L(0); PG8_BAR; PG8_MMA(1, 0, At, B0); PG8_MMA(1, 1, At, B1); PG8_BAR; PG8_SCHED;
            PG8_LDB(B0, 1, 0); PG8_LDB(B1, 1, 1); PG8_SCHED; PG8_LDA(At, 1, 0); PG8_STAGE(PG8_SA(0, 1), a2 + hstepA, voffA);
            PG8_WAIT_V(8); PG8_WAIT_L(0); PG8_BAR; PG8_MMA(0, 0, At, B0); PG8_MMA(0, 1, At, B1); PG8_BAR; PG8_SCHED;
            PG8_LDA(At, 1, 1); PG8_STAGE(PG8_SB(1, 0), b3, voffB); PG8_STAGE(PG8_SB(1, 1), b3 + hstepB, voffB); PG8_STAGE(PG8_SA(1, 0), a3, voffA);
            PG8_WAIT_V(8); PG8_WAIT_L(0); PG8_BAR; PG8_MMA(1, 0, At, B0); PG8_MMA(1, 1, At, B1); PG8_BAR; PG8_SCHED;
            } else {
            PG8_LDB(B0, 0, 0); PG8_SCHED; PG8_LDA(At, 0, 0); PG8_STAGE(PG8_SA(1, 1), a1 + hstepA, voffA);
            PG8_WAIT_L(8); PG8_BAR; PG8_WAIT_L(0); PG8_MMA(0, 0, At, B0); PG8_BAR; PG8_SCHED;
            PG8_LDB(B1, 0, 1); PG8_STAGE(PG8_SB(0, 0), b2, voffB);
            PG8_BAR; PG8_WAIT_L(0); PG8_MMA(0, 1, At, B1); PG8_BAR;
            PG8_LDA(At, 0, 1); PG8_STAGE(PG8_SA(0, 0), a2, voffA);
            PG8_BAR; PG8_WAIT_L(0); PG8_MMA(1, 0, At, B0); PG8_BAR; PG8_SCHED;
            PG8_STAGE(PG8_SB(0, 1), b2 + hstepB, voffB);
            PG8_WAIT_V(6); PG8_BAR; PG8_MMA(1, 1, At, B1); PG8_BAR;
            PG8_LDB(B0, 1, 0); PG8_SCHED; PG8_LDA(At, 1, 0); PG8_STAGE(PG8_SA(0, 1), a2 + hstepA, voffA);
            PG8_WAIT_L(8); PG8_BAR; PG8_WAIT_L(0); PG8_MMA(0, 0, At, B0); PG8_BAR; PG8_SCHED;
            PG8_LDB(B1, 1, 1); PG8_STAGE(PG8_SB(1, 0), b3, voffB);
            PG8_BAR; PG8_WAIT_L(0); PG8_MMA(0, 1, At, B1); PG8_BAR;
            PG8_LDA(At, 1, 1); PG8_STAGE(PG8_SA(1, 0), a3, voffA);
            PG8_BAR; PG8_WAIT_L(0); PG8_MMA(1, 0, At, B0); PG8_BAR; PG8_SCHED;
            PG8_STAGE(PG8_SB(1, 1), b3 + hstepB, voffB);
            PG8_WAIT_V(6); PG8_BAR; PG8_MMA(1, 1, At, B1); PG8_BAR;
            }
        }
        if constexpr (ALIGN_EPI) { if (wr == 0) PG8_BAR; }
        if constexpr (!Epi::AFTER_DRAIN) { E(acc, cur, wr, wc, fr, fq); S.done(cur); }
        if (!has_next) break;
#pragma unroll
        for (int a = 0; a < 2; ++a)
#pragma unroll
            for (int b = 0; b < 2; ++b)
#pragma unroll
                for (int m = 0; m < 4; ++m)
#pragma unroll
                    for (int n = 0; n < 2; ++n) acc[a][b][m][n] = (f32x4){0.f, 0.f, 0.f, 0.f};
        cur = nxt; cA = nA; cB = nB; ++ui;
        if constexpr (ALIGN_EPI) { if (wr == 1) PG8_BAR; }
    }
    PG8_WAIT_V(0);
    if constexpr (!ALIGN_EPI) { if (wr == 0) PG8_BAR; }
    PG8_BAR;
    if constexpr (Epi::AFTER_DRAIN) { E.fused(acc, cur, wr, wc, fr, fq, lds, wid, lane); S.done(cur); }
#undef PG8_SA
#undef PG8_SB
#undef PG8_STAGE
#undef PG8_LDA
#undef PG8_LDB
#undef PG8_MMA
#undef PG8_WAIT_V
#undef PG8_WAIT_L
#undef PG8_BAR
#undef PG8_SCHED
}
}


#define XB_TMO      128
#define XB_XCNT(j)  (256  + 64 * (j))
#define XB_XSUB(j)  (1280 + 64 * (j))
#define XB_XGEN(j)  (2304 + 64 * (j))
#define XB_TOP      3328
#define XB_TOPGEN   3392
#define XCD_BAR_WORDS 3456
#define XB_SPIN_CAP (1u << 18)
__device__ __forceinline__ unsigned xb_ld(unsigned* p)              { return __hip_atomic_load(p, __ATOMIC_RELAXED, __HIP_MEMORY_SCOPE_AGENT); }
__device__ __forceinline__ unsigned xb_add(unsigned* p, unsigned v) { return __hip_atomic_fetch_add(p, v, __ATOMIC_RELAXED, __HIP_MEMORY_SCOPE_AGENT); }
__device__ __forceinline__ unsigned xb_xcc_id() { return (unsigned)__builtin_amdgcn_s_getreg((3 << 11) | 20) & 0xFu; }
#define XB_SPIN(cond, bar) do { unsigned _sp = 0; while (cond) { __builtin_amdgcn_s_sleep(1); \
    if ((++_sp & 255u) == 0u) { if (xb_ld(&(bar)[XB_TMO])) break; if (_sp > XB_SPIN_CAP) { atomicAdd(&(bar)[XB_TMO], 1u); break; } } } } while (0)
struct XcdBarrier { unsigned* bar; unsigned x; volatile LAS unsigned* st; };
__device__ __forceinline__ XcdBarrier xcd_barrier_post(unsigned* bar, volatile LAS unsigned* st) {
    XcdBarrier b; b.bar = bar; b.x = xb_xcc_id(); b.st = st;
    if (threadIdx.x == 0) (void)xb_add(&bar[XB_XCNT(b.x)], 1u);
    return b;
}
__device__ __forceinline__ void xcd_barrier_complete(unsigned* bar, unsigned x, unsigned& nloc, unsigned& nx) {
    const unsigned G = gridDim.x * gridDim.y * gridDim.z;
    unsigned sum, cnt, mine, sp = 0u;
    for (;;) {
        sum = 0u; cnt = 0u; mine = 0u;
#pragma unroll
        for (unsigned j = 0; j < 16; ++j) { const unsigned c = xb_ld(&bar[XB_XCNT(j)]); sum += c; cnt += (c > 0u) ? 1u : 0u; mine = (j == x) ? c : mine; }
        if (sum == G) break;
        __builtin_amdgcn_s_sleep(1);
        if ((++sp & 255u) == 0u) { if (xb_ld(&bar[XB_TMO])) break; if (sp > XB_SPIN_CAP) { atomicAdd(&bar[XB_TMO], 1u); break; } }
    }
    nloc = mine > 0u ? mine : 1u; nx = cnt > 0u ? cnt : 1u;
}
__device__ __forceinline__ void xcd_barrier(const XcdBarrier& b) {
    asm volatile("s_waitcnt vmcnt(0)" ::: "memory");
    __syncthreads();
    if (threadIdx.x == 0) {
        unsigned* bar = b.bar;
        __builtin_amdgcn_s_waitcnt(0);
        unsigned nloc = b.st[0], nx = b.st[1];
        if (nloc == 0u) { xcd_barrier_complete(bar, b.x, nloc, nx); b.st[0] = nloc; b.st[1] = nx; }
        const unsigned old = xb_add(&bar[XB_XSUB(b.x)], 1u);
        const unsigned gen = old / nloc;
        if (old + 1u == (gen + 1u) * nloc) {
            __builtin_amdgcn_fence(__ATOMIC_RELEASE, "agent");
            asm volatile("s_waitcnt vmcnt(0)" ::: "memory");
            const unsigned og = xb_add(&bar[XB_TOP], 1u);
            const unsigned tg = og / nx;
            if (og + 1u == (tg + 1u) * nx) xb_add(&bar[XB_TOPGEN], 1u);
            else XB_SPIN(xb_ld(&bar[XB_TOPGEN]) == tg, bar);
            __builtin_amdgcn_fence(__ATOMIC_ACQUIRE, "agent");
            xb_add(&bar[XB_XGEN(b.x)], 1u);
            asm volatile("s_waitcnt vmcnt(0)" ::: "memory");
        } else {
            XB_SPIN(xb_ld(&bar[XB_XGEN(b.x)]) == gen, bar);
            __builtin_amdgcn_fence(__ATOMIC_ACQUIRE, "agent");
            asm volatile("s_waitcnt vmcnt(0)" ::: "memory");
        }
    }
    __syncthreads();
}

struct MkArgs { const float* in[27]; float* out; unsigned char* ws; };
struct Frame { LAS unsigned char* lds; int tid, lane, wave, bid, G; };

__device__ __forceinline__ void mod_partial_item(const Frame& F, int item, const float* c, const float* cc_, const float* w_mod, float* MODP) {
    const int kc = item >> 4, cc = item & 15, kq = F.tid >> 7, cq = F.tid & 127;
    LAS float* red = (LAS float*)F.lds;
    float a0[3] = {0.f, 0.f, 0.f}, a1[3] = {0.f, 0.f, 0.f};
#pragma unroll 4
    for (int kk = 0; kk < 16; ++kk) { const int k = kc * 64 + kq * 16 + kk; const float s0 = siluf_(c[k]), s1 = siluf_(cc_[k]); const float* wr = w_mod + (size_t)k * (6 * D) + cc * 384 + cq;
#pragma unroll
        for (int j = 0; j < 3; ++j) { const float w = wr[128 * j]; a0[j] += s0 * w; a1[j] += s1 * w; } }
    __syncthreads();
#pragma unroll
    for (int j = 0; j < 3; ++j) { red[(kq * 2 + 0) * 384 + cq + 128 * j] = a0[j]; red[(kq * 2 + 1) * 384 + cq + 128 * j] = a1[j]; }
    __syncthreads();
    for (int e = F.tid; e < 768; e += 512) { const int set = e / 384, col = e % 384;
        MODP[((size_t)kc * 2 + set) * (6 * D) + cc * 384 + col] = (red[(0 * 2 + set) * 384 + col] + red[(1 * 2 + set) * 384 + col]) + (red[(2 * 2 + set) * 384 + col] + red[(3 * 2 + set) * 384 + col]); }
}
__device__ __forceinline__ float mod_sum(const float* MODP, const float* b_mod, int set, int n) {
    float s = b_mod[n];
#pragma unroll
    for (int kc = 0; kc < 16; ++kc) s += MODP[((size_t)kc * 2 + set) * (6 * D) + n];
    return s;
}
__device__ __forceinline__ int map_col(int kind, int n) {
    if (kind == 1) { if (n >= 1024) return n; const int pn = n >> 8, lc = n & 255; return lc < 128 ? 128 * pn + lc : 512 + 128 * pn + (lc - 128); }
    if (kind == 2) { const int q = n >> 8, lc = n & 255; return lc < 128 ? 128 * q + lc : DFF + 128 * q + (lc - 128); }
    return n;
}
__device__ __forceinline__ void transpose_item(const float* W, int K, int N, h16* WT, int kind, LAS float* scr, int item, int lane) {
    const int nblk = N / 32, kb = item / nblk, nb = item % nblk, k0 = 64 * kb, n0 = 32 * nb, src0 = map_col(kind, n0);
#pragma unroll 8
    for (int i = 0; i < 32; ++i) { const int kk = 2 * i + (lane >> 5); scr[kk * 33 + (lane & 31)] = W[(size_t)(k0 + kk) * N + src0 + (lane & 31)]; }
    asm volatile("s_waitcnt lgkmcnt(0)" ::: "memory");
    const int c = lane & 7;
#pragma unroll
    for (int j = 0; j < 4; ++j) { const int n = (lane >> 3) + 8 * j; const LAS float* s = scr + (8 * c) * 33 + n;
        u32x4g o; o.x = pk2(s[0 * 33], s[1 * 33]); o.y = pk2(s[2 * 33], s[3 * 33]); o.z = pk2(s[4 * 33], s[5 * 33]); o.w = pk2(s[6 * 33], s[7 * 33]);
        *(u32x4g*)(WT + (size_t)(n0 + n) * K + k0 + 8 * c) = o; }
    asm volatile("s_waitcnt lgkmcnt(0)" ::: "memory");
}
template <class ShP, class ScP>
__device__ __forceinline__ void norm_row(int lane, const float* xrow, const float* gain, ShP sh, ScP sc, h16* orow) {
    const f32x4* xr = (const f32x4*)xrow + lane;
    f32x4 v[4]; float s = 0.f;
#pragma unroll
    for (int j = 0; j < 4; ++j) { v[j] = xr[64 * j]; s += (v[j].x * v[j].x + v[j].y * v[j].y) + (v[j].z * v[j].z + v[j].w * v[j].w); }
    const float rstd = rsqrtf(wave_sum(s) * (1.f / D) + EPS);
    unsigned long long* o8 = (unsigned long long*)orow + lane;
#pragma unroll
    for (int j = 0; j < 4; ++j) { const f32x4 g = ((const f32x4*)gain)[lane + 64 * j], a = sh[lane + 64 * j], b = sc[lane + 64 * j];
        const f32x4 y = (v[j] * rstd) * g * (1.f + b) + a;
        o8[64 * j] = (unsigned long long)pk2(y.x, y.y) | ((unsigned long long)pk2(y.z, y.w) << 32); }
}
__device__ __forceinline__ void conv_items(const Frame& F, int first, int stride, const h16* Aconv, const float* cw, const float* cb, const float* lg, const float* lb, h16* MIX) {
    LAS unsigned char* tile = F.lds;
    LAS f32x2* part = (LAS f32x2*)(F.lds + 64 * 1024);
    const int half = F.wave & 1, q = F.wave >> 1, ch0 = half * 256 + F.lane * 4;
    float w[CW][4];
#pragma unroll
    for (int k = 0; k < CW; ++k) { const f32x4 t = *(const f32x4*)(cw + k * DC + ch0); w[k][0] = t.x; w[k][1] = t.y; w[k][2] = t.z; w[k][3] = t.w; }
    const f32x4 bias = *(const f32x4*)(cb + ch0), gln = *(const f32x4*)(lg + ch0), bln = *(const f32x4*)(lb + ch0);
    for (int item = first; item < GW * 8; item += stride) {
        const int c = item & 63, rb = item >> 6;
        __syncthreads();
        for (int idx = F.tid; idx < 62 * 64; idx += 512) { const int row = idx >> 6, piece = idx & 63, rr = 32 * rb - 15 + row;
            u32x4g v = {0u, 0u, 0u, 0u};
            if (rr >= 0 && rr < ROWS) v = *(const u32x4g*)(Aconv + ((size_t)(rr * GW + c)) * DC + piece * 8);
            *(LAS u32x4g*)(tile + row * 1024 + piece * 16) = v; }
        __syncthreads();
        for (int it = 0; it < 8; ++it) {
            const int lr = it * 4 + q;
            float y0 = bias.x, y1 = bias.y, y2 = bias.z, y3 = bias.w;
#pragma unroll
            for (int k = 0; k < CW; ++k) { const u32x2g a = *(const LAS u32x2g*)(tile + (lr + k) * 1024 + ch0 * 2);
                y0 += w[k][0] * __uint_as_float(a.x << 16); y1 += w[k][1] * __uint_as_float(a.x & 0xffff0000u);
                y2 += w[k][2] * __uint_as_float(a.y << 16); y3 += w[k][3] * __uint_as_float(a.y & 0xffff0000u); }
            const float s1 = wave_sum((y0 + y1) + (y2 + y3)), s2 = wave_sum((y0 * y0 + y1 * y1) + (y2 * y2 + y3 * y3));
            if (F.lane == 0) part[((it & 1) * 4 + q) * 2 + half] = (f32x2){s1, s2};
            __syncthreads();
            const f32x2 pa = part[((it & 1) * 4 + q) * 2 + 0], pb = part[((it & 1) * 4 + q) * 2 + 1];
            const float mu = (pa.x + pb.x) * (1.f / DC), var = fmaxf((pa.y + pb.y) * (1.f / DC) - mu * mu, 0.f), rstd = rsqrtf(var + EPS);
            const float o0 = siluf_((y0 - mu) * rstd * gln.x + bln.x), o1 = siluf_((y1 - mu) * rstd * gln.y + bln.y), o2 = siluf_((y2 - mu) * rstd * gln.z + bln.z), o3 = siluf_((y3 - mu) * rstd * gln.w + bln.w);
            const int t = (32 * rb + lr) * GW + c;
            *(u32x2g*)(MIX + (size_t)t * 1024 + ch0) = (u32x2g){pk2(o0, o1), pk2(o2, o3)};
        }
    }
}

__global__ void __launch_bounds__(512, 2) mk_fwd(MkArgs a) {
    extern __shared__ __attribute__((aligned(16))) unsigned char lds_raw[];
    Frame F; F.lds = (LAS unsigned char*)lds_raw; F.tid = threadIdx.x; F.lane = F.tid & 63; F.wave = __builtin_amdgcn_readfirstlane(F.tid >> 6); F.bid = blockIdx.x; F.G = gridDim.x;
    const int gw = F.bid * 8 + F.wave, NGW = F.G * 8, gtid = F.bid * 512 + F.tid, NGT = F.G * 512;
    volatile LAS unsigned* MISC = (volatile LAS unsigned*)(F.lds + MISC_OFF);
    const float* x = a.in[0]; const float* c = a.in[1]; const float* ctx = a.in[2]; const float* c_ctx = a.in[3];
    const float* w_mod = a.in[4]; const float* b_mod = a.in[5]; const float* norm1_g = a.in[6]; const float* w_in = a.in[7];
    const float* conv_w = a.in[8]; const float* conv_b = a.in[9]; const float* conv_ln_g = a.in[10]; const float* conv_ln_b = a.in[11];
    const float* a_re = a.in[12]; const float* a_im = a.in[13]; const float* log_dt = a.in[14];
    const float* b_re = a.in[15]; const float* b_im = a.in[16]; const float* c_re = a.in[17]; const float* c_im = a.in[18];
    const float* ssm_d = a.in[19]; const float* w_glu = a.in[20]; const float* b_glu = a.in[21]; const float* w_out = a.in[22];
    const float* norm2_g = a.in[23]; const float* w_gu = a.in[24]; const float* w_dn = a.in[25]; const float* fin_g = a.in[26];
    unsigned char* ws = a.ws; float* out = a.out;
    unsigned* ctl = (unsigned*)(ws + WS_CTL);
    float* MOD = (float*)(ws + WS_MOD); float* MODP = (float*)(ws + WS_MODP);
    h16* WinT = (h16*)(ws + WS_WIN); h16* WgluT = (h16*)(ws + WS_WGLU); h16* WoutT = (h16*)(ws + WS_WOUT); h16* WguT = (h16*)(ws + WS_WGU); h16* WdnT = (h16*)(ws + WS_WDN);
    h16* H = (h16*)(ws + WS_H); h16* Aconv = (h16*)(ws + WS_ACONV); h16* Uext = (h16*)(ws + WS_UEXT); float* Uctx = (float*)(ws + WS_UCTX);
    h16* ACT = (h16*)(ws + WS_ACT); h16* Gact = (h16*)(ws + WS_GACT); h16* MIX = (h16*)(ws + WS_MIX); h16* H2 = (h16*)(ws + WS_H2);
    float* KTAB = (float*)(ws + WS_KTAB); h16* WyT = (h16*)(ws + WS_WY); h16* PT = (h16*)(ws + WS_PT); float2* Ectx = (float2*)(ws + WS_ECTX); float* Ebuf = (float*)(ws + WS_E);

    for (int u = F.tid; u < (LDS_BYTES - LDSCTL_OFF) / 4; u += 512) ((LAS unsigned*)(F.lds + LDSCTL_OFF))[u] = 0u;
    __syncthreads();
    const XcdBarrier bar = xcd_barrier_post(ctl + CW_BAR, MISC + 8);
#define GRID_BAR() xcd_barrier(bar)

    for (int item = F.bid; item < 256; item += F.G) mod_partial_item(F, item, c, c_ctx, w_mod, MODP);
    for (int item = F.bid; item < NG * 2 * 4; item += F.G)
        ktab_item(item, F.tid, (LAS f32x2*)(F.lds + 16384), (LAS f32x2*)(F.lds + 16384 + 8192), (LAS f32x2*)(F.lds + 16384 + 16384), a_re, a_im, log_dt, b_re, b_im, c_re, c_im, KTAB);
    __syncthreads();
    {
        LAS float* scr = (LAS float*)(F.lds + F.wave * 16384);
        constexpr int I_IN = (D / 64) * (DIN / 32), I_GLU = (DS / 64) * (DS / 32), I_OUT = (D / 64) * (D / 32), I_GU = (D / 64) * (2 * DFF / 32), I_DN = (DFF / 64) * (D / 32);
        for (int it = gw; it < I_IN + I_GLU + I_OUT + I_GU + I_DN; it += NGW) {
            int r = it;
            if (r < I_IN) { transpose_item(w_in, D, DIN, WinT, 1, scr, r, F.lane); continue; } r -= I_IN;
            if (r < I_GLU) { transpose_item(w_glu, DS, DS, WgluT, 0, scr, r, F.lane); continue; } r -= I_GLU;
            if (r < I_OUT) { transpose_item(w_out, D, D, WoutT, 0, scr, r, F.lane); continue; } r -= I_OUT;
            if (r < I_GU) { transpose_item(w_gu, D, 2 * DFF, WguT, 2, scr, r, F.lane); continue; } r -= I_GU;
            transpose_item(w_dn, DFF, D, WdnT, 0, scr, r, F.lane);
        }
    }
    for (size_t i = gtid; i < (size_t)NG * 32 * 2 * 64; i += NGT) wy_q(i, a_re, a_im, log_dt, c_re, c_im, WyT);
    for (size_t i = gtid; i < (size_t)NG * 2 * 64 * 32; i += NGT) pt_fill(i, a_re, a_im, log_dt, b_re, b_im, PT);
    GRID_BAR();

    {
        LAS float* modl = (LAS float*)F.lds;
        for (int e = F.tid; e < 4096; e += 512) { const int which = e >> 10, k = e & 1023; modl[e] = mod_sum(MODP, b_mod, which >> 1, (which & 1) * D + k); }
        for (int e = gtid; e < 2 * 6 * D; e += NGT) { const int set = e / (6 * D), n = e % (6 * D); MOD[e] = mod_sum(MODP, b_mod, set, n); }
        __syncthreads();
        for (int m = gw; m < MR; m += NGW) { const bool lat = m < L; const LAS f32x4* sh = (const LAS f32x4*)(modl + (lat ? 0 : 2048)); const LAS f32x4* sc = sh + 256;
            norm_row(F.lane, lat ? x + (size_t)m * D : ctx + (size_t)(m - L) * D, norm1_g, sh, sc, H + (size_t)m * D); }
        for (size_t i = gtid; i < (size_t)NG * 32 * 16 * 32; i += NGT) wy_toep(i, KTAB, ssm_d, WyT);
    }
    GRID_BAR();

    { pg8::Gemm g{(const char*)H, (const char*)WinT, 2 * D, 32, 0, 2 * D, 0, D}; pg8::StaticOrder S; S.init(L, DIN, F.G, F.bid); S.extra = 2;
      pg8::EpiG1 E{Aconv, Uext, Uctx}; pg8::gemm_phase<pg8::EpiG1, pg8::StaticOrder, true, true>(F.lds, g, S, E); }
    GRID_BAR();

    { pg8::Gemm g{(const char*)Uext, (const char*)PT, 2 * KY, 32, (long)NC * KY * 2, 2 * 512, 256L * 512 * 2, 512}; pg8::BatchOrder S; S.init(NG, 2, 1, F.G, F.bid);
      pg8::EpiE E{Ebuf, 0}; pg8::gemm_phase<pg8::EpiE, pg8::BatchOrder, false, true>(F.lds, g, S, E); }
    if (F.bid >= 64) { for (int item = gw - 64 * 8; item < 2 * NG * 8; item += NGW - 64 * 8) ctx_chunk_state(item, F.lane, a_re, a_im, log_dt, b_re, b_im, Uctx, Ectx); }
    __syncthreads();
    conv_items(F, F.bid, F.G, Aconv, conv_w, conv_b, conv_ln_g, conv_ln_b, MIX);
    GRID_BAR();

    for (int item = F.bid; item < NG * 4; item += F.G) scan_item(item, F.tid, (LAS f32x2*)F.lds, a_re, a_im, log_dt, Ectx, Ebuf, Uext);
    GRID_BAR();

    { pg8::Gemm g{(const char*)Uext, (const char*)WyT, 2 * KY, 32, (long)NC * KY * 2, 2 * KY, 512L * KY * 2, KY}; pg8::BatchOrder S; S.init(NG, 2, 2, F.G, F.bid);
      pg8::EpiY E{Gact, 0}; pg8::gemm_phase<pg8::EpiY, pg8::BatchOrder, false, true>(F.lds, g, S, E); }
    GRID_BAR();

    { pg8::Gemm g{(const char*)Gact, (const char*)WgluT, 32, (long)L * 32, 0, 2 * DS, 0, DS}; pg8::StaticOrder S; S.init(L, DS, F.G, F.bid);
      pg8::EpiGluF E{Gact, b_glu, MIX}; pg8::gemm_phase<pg8::EpiGluF, pg8::StaticOrder, false, true>(F.lds, g, S, E); }
    GRID_BAR();

    { pg8::Gemm g{(const char*)MIX, (const char*)WoutT, 2 * D, 32, 0, 2 * D, 0, D}; pg8::StaticOrder S; S.init(L, D, F.G, F.bid);
      pg8::EpiResF E{x, MOD + 2 * D, out}; pg8::gemm_phase<pg8::EpiResF, pg8::StaticOrder, false, true>(F.lds, g, S, E); }
    GRID_BAR();

    for (int m = gw; m < L; m += NGW) norm_row(F.lane, out + (size_t)m * D, norm2_g, (const f32x4*)(MOD + 3 * D), (const f32x4*)(MOD + 4 * D), H2 + (size_t)m * D);
    GRID_BAR();

    { pg8::Gemm g{(const char*)H2, (const char*)WguT, 2 * D, 32, 0, 2 * D, 0, D}; pg8::StaticOrder S; S.init(L, 2 * DFF, F.G, F.bid);
      pg8::EpiFfn E{ACT, 0}; pg8::gemm_phase<pg8::EpiFfn, pg8::StaticOrder, true, true>(F.lds, g, S, E); }
    GRID_BAR();

    { pg8::Gemm g{(const char*)ACT, (const char*)WdnT, 2 * DFF, 32, 0, 2 * DFF, 0, DFF}; pg8::StaticOrder S; S.init(L, D, F.G, F.bid);
      pg8::EpiResF E{out, MOD + 5 * D, out}; pg8::gemm_phase<pg8::EpiResF, pg8::StaticOrder, false, true>(F.lds, g, S, E); }
    GRID_BAR();

    for (int m = gw; m < L; m += NGW) { f32x4* xr = (f32x4*)(out + (size_t)m * D) + F.lane; f32x4 v[4]; float s = 0.f;
#pragma unroll
        for (int j = 0; j < 4; ++j) { v[j] = xr[64 * j]; s += (v[j].x * v[j].x + v[j].y * v[j].y) + (v[j].z * v[j].z + v[j].w * v[j].w); }
        const float rstd = rsqrtf(wave_sum(s) * (1.f / D) + EPS);
#pragma unroll
        for (int j = 0; j < 4; ++j) xr[64 * j] = (v[j] * rstd) * ((const f32x4*)fin_g)[F.lane + 64 * j]; }
}

extern "C" void kernel_launch(void* const* d_in, const int* in_sizes, int n_in, void* d_out, int out_size, void* d_ws, size_t ws_size, hipStream_t stream) {
    static int grid = 0;
    if (grid == 0) {
        if (n_in != 27 || in_sizes[0] != L * D || out_size != L * D || ws_size < WS_END) { fprintf(stderr, "kernel_launch: unexpected problem (n_in %d, x %d, out %d, ws %zu)\n", n_in, n_in > 0 ? in_sizes[0] : -1, out_size, ws_size); grid = -1; return; }
        int dev = 0, cus = 0, per_cu = 0;
        if (hipGetDevice(&dev) != hipSuccess || hipDeviceGetAttribute(&cus, hipDeviceAttributeMultiprocessorCount, dev) != hipSuccess) { grid = -1; return; }
        if (hipFuncSetAttribute((const void*)mk_fwd, hipFuncAttributeMaxDynamicSharedMemorySize, LDS_BYTES) != hipSuccess) { fprintf(stderr, "kernel_launch: cannot get %d B of LDS\n", LDS_BYTES); grid = -1; return; }
        if (hipOccupancyMaxActiveBlocksPerMultiprocessor(&per_cu, (const void*)mk_fwd, 512, LDS_BYTES) != hipSuccess || per_cu < 1) { fprintf(stderr, "kernel_launch: occupancy query says %d\n", per_cu); (void)hipGetLastError(); grid = -1; return; }
        grid = cus * 1;
        if (grid > 256) grid = 256;
        if (grid < 128) { fprintf(stderr, "kernel_launch: %d CUs is fewer than this kernel's phases assume\n", cus); grid = -1; return; }
    }
    if (grid < 0) return;
    if (hipMemsetAsync((char*)d_ws + WS_CTL, 0, CTL_ZERO_BYTES, stream) != hipSuccess) { fprintf(stderr, "kernel_launch: memset failed\n"); return; }
    MkArgs a{};
    for (int i = 0; i < 27; ++i) a.in[i] = (const float*)d_in[i];
    a.out = (float*)d_out; a.ws = (unsigned char*)d_ws;
    void* args[] = {&a};
    const hipError_t e = hipLaunchCooperativeKernel((const void*)mk_fwd, dim3(grid), dim3(512), args, LDS_BYTES, stream);
    if (e != hipSuccess) fprintf(stderr, "kernel_launch: cooperative launch failed: %s (grid %d)\n", hipGetErrorString(e), grid);
}
```
